# Optimizing an MI355X kernel written in HIP

```python
import jax
import jax.numpy as jnp
from jax import lax
import numpy as np

D_MODEL = 1024
BATCH = 16
SEQ = 2048
DEPTH = 2

GRID_W = 64
ROPE_THETA = 10000.0
NORM_EPS = 1e-6
Q_BLOCK = 128
N_BRANCH = 4

SSD_HEADS = 16
SSD_HEAD_DIM = 64
SSD_INNER = SSD_HEADS * SSD_HEAD_DIM
SSD_GROUPS = 2
SSD_STATE = 128
SSD_CONV = 5
SSD_CHUNK = 128
SSD_CONV_DIM = SSD_INNER + 2 * SSD_GROUPS * SSD_STATE

MLA_HEADS = 8
MLA_Q_RANK = 384
MLA_KV_RANK = 256
MLA_NOPE = 64
MLA_ROPE = 32
MLA_V = 64
MLA_WIDTH = MLA_HEADS * MLA_V

GLA_HEADS = 4
GLA_DK = 64
GLA_DV = 128
GLA_GATE_RANK = 16
GLA_TAU = 16.0
GLA_CHUNK = 64
GLA_WIDTH = GLA_HEADS * GLA_DV

GQA_HEADS = 8
GQA_KV_HEADS = 2
GQA_HEAD_DIM = 64
GQA_WIDTH = GQA_HEADS * GQA_HEAD_DIM

IN_WIDTHS = (
    N_BRANCH * D_MODEL,
    SSD_INNER,
    SSD_CONV_DIM,
    2 * SSD_HEADS,
    MLA_WIDTH,
    MLA_Q_RANK,
    MLA_KV_RANK,
    MLA_ROPE,
    GLA_WIDTH,
    GLA_HEADS * GLA_DK,
    GLA_HEADS * GLA_DK,
    GLA_WIDTH,
    2 * GLA_GATE_RANK,
    GQA_WIDTH,
    GQA_WIDTH,
    GQA_KV_HEADS * GQA_HEAD_DIM,
    GQA_KV_HEADS * GQA_HEAD_DIM,
)
N_IN = sum(IN_WIDTHS)

kernel_name = 'hybrid_gated_branch_encoder'


def rmsnorm(x, g):
    xf = x.astype(jnp.float32)
    y = xf * lax.rsqrt(jnp.mean(xf * xf, axis=-1, keepdims=True) + NORM_EPS)
    return (y * g.astype(jnp.float32)).astype(x.dtype)


def rev(t):
    return jnp.flip(t, axis=1)


def axial_rope_tables(rows, d_rot):
    row = jnp.repeat(jnp.arange(rows), GRID_W).astype(jnp.float32)
    col = jnp.tile(jnp.arange(GRID_W), rows).astype(jnp.float32)
    m = d_rot // 2
    inv = ROPE_THETA ** (-jnp.arange(0, m, 2, dtype=jnp.float32) / m)
    ang_r = row[:, None] * inv
    ang_c = col[:, None] * inv
    ang = jnp.concatenate([ang_r, ang_r, ang_c, ang_c], axis=-1)
    return jnp.cos(ang), jnp.sin(ang)


def apply_axial_rope(x, cos, sin):
    d = x.shape[-1]
    m = d // 2
    hm = m // 2
    xf = x.astype(jnp.float32)
    x1 = xf[..., :m]
    x2 = xf[..., m:]
    rot = jnp.concatenate([-x1[..., hm:], x1[..., :hm], -x2[..., hm:], x2[..., :hm]], axis=-1)
    return (xf * cos[None, :, None, :] + rot * sin[None, :, None, :]).astype(x.dtype)


def block_attention(q, k, v, scale):
    b, L, hq, d = q.shape
    hk = k.shape[2]
    r = hq // hk
    dv = v.shape[-1]
    nb = L // Q_BLOCK
    qb = q.reshape(b, nb, Q_BLOCK, hk, r, d).transpose(1, 0, 2, 3, 4, 5)

    def one_block(qblk):
        s = jnp.einsum('bqgrd,bkgd->bgrqk', qblk, k).astype(jnp.float32) * scale
        p = jax.nn.softmax(s, axis=-1).astype(v.dtype)
        return jnp.einsum('bgrqk,bkgv->bqgrv', p, v)

    o = lax.map(one_block, qb)
    return o.transpose(1, 0, 2, 3, 4, 5).reshape(b, L, hq * dv)


def centred_depthwise_conv(u, w, bias):
    pad = (SSD_CONV - 1) // 2
    y = lax.conv_general_dilated(u, w[:, None, :].astype(u.dtype), window_strides=(1,),
                                 padding=[(pad, pad)], dimension_numbers=('NWC', 'WIO', 'NWC'),
                                 feature_group_count=u.shape[-1])
    return y + bias.astype(u.dtype)


def ssd_chunked(x, dt, a_neg, bm, cm):
    b, L, H, P = x.shape
    G, N = bm.shape[2], bm.shape[3]
    E = H // G
    Q = SSD_CHUNK
    nc = L // Q
    xd = (x.astype(jnp.float32) * dt[..., None]).astype(x.dtype).reshape(b, nc, Q, G, E, P)
    a_cum = jnp.cumsum((dt * a_neg).reshape(b, nc, Q, G, E), axis=2)
    bc = bm.reshape(b, nc, Q, G, N)
    cc = cm.reshape(b, nc, Q, G, N)
    tri = jnp.tril(jnp.ones((Q, Q), dtype=bool))
    seg = a_cum[:, :, :, None] - a_cum[:, :, None, :]
    decay = jnp.exp(jnp.where(tri[None, None, :, :, None, None], seg, -jnp.inf)).astype(x.dtype)
    cb = jnp.einsum('bclgn,bcsgn->bclsg', cc, bc)
    y_diag = jnp.einsum('bclsge,bcsgep->bclgep', cb[..., None] * decay, xd)
    decay_end = jnp.exp(a_cum[:, :, -1:] - a_cum).astype(x.dtype)
    states = jnp.einsum('bcsgn,bcsgep->bcgepn', bc, xd * decay_end[..., None])
    chunk_decay = jnp.exp(a_cum[:, :, -1]).astype(x.dtype)

    def step(s, inp):
        dec, st = inp
        return dec[..., None, None] * s + st, s

    s0 = jnp.zeros_like(states[:, 0])
    _, s_prev = lax.scan(step, s0, (chunk_decay.transpose(1, 0, 2, 3),
                                    states.transpose(1, 0, 2, 3, 4, 5)))
    s_prev = s_prev.transpose(1, 0, 2, 3, 4, 5)
    y_off = jnp.einsum('bclgn,bcgepn->bclgep', cc, s_prev) * jnp.exp(a_cum).astype(x.dtype)[..., None]
    return (y_diag + y_off).reshape(b, L, H, P)


def gla_chunked(q, k, v, g_log):
    b, L, H, K = q.shape
    V = v.shape[-1]
    Q = GLA_CHUNK
    nc = L // Q
    g_cum = jnp.cumsum(g_log.reshape(b, nc, Q, H, K), axis=2)
    qc = q.reshape(b, nc, Q, H, K).astype(jnp.float32)
    kc = k.reshape(b, nc, Q, H, K).astype(jnp.float32)
    vc = v.reshape(b, nc, Q, H, V)
    qg = (qc * jnp.exp(g_cum)).astype(q.dtype)
    kg = (kc * jnp.exp(-g_cum)).astype(q.dtype)
    k_end = (kc * jnp.exp(g_cum[:, :, -1:] - g_cum)).astype(q.dtype)
    tri = jnp.tril(jnp.ones((Q, Q), dtype=bool))
    att = jnp.einsum('bclhk,bcshk->bchls', qg, kg)
    att = jnp.where(tri, att, jnp.zeros((), att.dtype))
    o_intra = jnp.einsum('bchls,bcshv->bclhv', att, vc)
    u = jnp.einsum('bcshk,bcshv->bchkv', k_end, vc)
    chunk_decay = jnp.exp(g_cum[:, :, -1]).astype(q.dtype)

    def step(s, inp):
        dec, st = inp
        return dec[..., None] * s + st, s

    s0 = jnp.zeros_like(u[:, 0])
    _, s_prev = lax.scan(step, s0, (chunk_decay.transpose(1, 0, 2, 3),
                                    u.transpose(1, 0, 2, 3, 4)))
    s_prev = s_prev.transpose(1, 0, 2, 3, 4)
    o_inter = jnp.einsum('bclhk,bchkv->bclhv', qg, s_prev)
    return (o_intra + o_inter).reshape(b, L, H, V)


def ssd_branch(z, xbc, dt_raw, conv_w, conv_b, a_log, dt_bias, d_skip, norm_g, w_br):
    b, L, _ = xbc.shape
    xbc = jax.nn.silu(centred_depthwise_conv(xbc, conv_w, conv_b))
    xs, bm, cm = jnp.split(xbc, [SSD_INNER, SSD_INNER + SSD_GROUPS * SSD_STATE], axis=-1)
    xs = xs.reshape(b, L, SSD_HEADS, SSD_HEAD_DIM)
    bm = bm.reshape(b, L, SSD_GROUPS, SSD_STATE)
    cm = cm.reshape(b, L, SSD_GROUPS, SSD_STATE)
    dt = jax.nn.softplus(dt_raw.astype(jnp.float32).reshape(b, L, 2, SSD_HEADS)
                         + dt_bias.astype(jnp.float32))
    a_neg = -jnp.exp(a_log.astype(jnp.float32))
    y_f = ssd_chunked(xs, dt[:, :, 0], a_neg[0], bm, cm)
    y_b = rev(ssd_chunked(rev(xs), rev(dt[:, :, 1]), a_neg[1], rev(bm), rev(cm)))
    y = (y_f + y_b + xs * d_skip[:, None].astype(xs.dtype)).reshape(b, L, SSD_INNER)
    return rmsnorm(y * jax.nn.silu(z), norm_g) @ w_br


def mla_branch(z, q_lat, kv_lat, k_rope, q_lat_norm_g, kv_lat_norm_g, w_q_b, w_kv_b, w_br, cos, sin):
    b, L, _ = q_lat.shape
    q = (rmsnorm(q_lat, q_lat_norm_g) @ w_q_b).reshape(b, L, MLA_HEADS, MLA_NOPE + MLA_ROPE)
    q = jnp.concatenate([q[..., :MLA_NOPE], apply_axial_rope(q[..., MLA_NOPE:], cos, sin)], axis=-1)
    kv = (rmsnorm(kv_lat, kv_lat_norm_g) @ w_kv_b).reshape(b, L, MLA_HEADS, MLA_NOPE + MLA_V)
    k_nope = kv[..., :MLA_NOPE]
    v = kv[..., MLA_NOPE:]
    k_r = apply_axial_rope(k_rope.reshape(b, L, 1, MLA_ROPE), cos, sin)
    k = jnp.concatenate([k_nope, jnp.broadcast_to(k_r, (b, L, MLA_HEADS, MLA_ROPE))], axis=-1)
    o = block_attention(q, k, v, (MLA_NOPE + MLA_ROPE) ** -0.5)
    return (o * jax.nn.silu(z)) @ w_br


def gla_branch(z, q_c, k_c, v_c, g_lr, w_gate_up, b_gate, norm_g, w_br):
    b, L, _ = q_c.shape
    q = q_c.reshape(b, L, GLA_HEADS, GLA_DK) * (GLA_DK ** -0.5)
    k = k_c.reshape(b, L, GLA_HEADS, GLA_DK)
    v = v_c.reshape(b, L, GLA_HEADS, GLA_DV)
    g_pre = jnp.einsum('blnr,nrk->blnk', g_lr.astype(jnp.float32).reshape(b, L, 2, GLA_GATE_RANK),
                       w_gate_up.astype(jnp.float32)) + b_gate.astype(jnp.float32)
    g_log = jax.nn.log_sigmoid(g_pre) / GLA_TAU
    g_f = g_log[:, :, 0].reshape(b, L, GLA_HEADS, GLA_DK)
    g_b = g_log[:, :, 1].reshape(b, L, GLA_HEADS, GLA_DK)
    o = gla_chunked(q, k, v, g_f) + rev(gla_chunked(rev(q), rev(k), rev(v), rev(g_b)))
    o = rmsnorm(o, norm_g.reshape(GLA_HEADS, GLA_DV)).reshape(b, L, GLA_WIDTH)
    return (o * jax.nn.silu(z)) @ w_br


def gqa_branch(z, q_d, k_d, v_d, q_norm_g, k_norm_g, w_br, cos, sin):
    b, L, _ = q_d.shape
    q = rmsnorm(q_d.reshape(b, L, GQA_HEADS, GQA_HEAD_DIM), q_norm_g)
    k = rmsnorm(k_d.reshape(b, L, GQA_KV_HEADS, GQA_HEAD_DIM), k_norm_g)
    q = apply_axial_rope(q, cos, sin)
    k = apply_axial_rope(k, cos, sin)
    v = v_d.reshape(b, L, GQA_KV_HEADS, GQA_HEAD_DIM)
    o = block_attention(q, k, v, GQA_HEAD_DIM ** -0.5)
    return (o * jax.nn.silu(z)) @ w_br


def setup_inputs(seed: int = 0) -> dict:
    key = jax.random.key(seed)
    ks = jax.random.split(key, 32)
    f32 = jnp.float32

    def nrm(k, shape, scale):
        return jax.random.normal(k, shape, f32) * scale

    def gain(k, shape):
        return 1.0 + 0.02 * jax.random.normal(k, shape, f32)

    dt0 = jnp.exp(jax.random.uniform(ks[5], (DEPTH, 2, SSD_HEADS), f32, np.log(1e-3), np.log(1e-1)))
    return {
        'x': jax.random.normal(ks[0], (BATCH, SEQ, D_MODEL), f32),
        'norm_g': gain(ks[1], (DEPTH, D_MODEL)),
        'w_in': nrm(ks[2], (DEPTH, D_MODEL, N_IN), D_MODEL ** -0.5),
        'conv_w': nrm(ks[3], (DEPTH, SSD_CONV, SSD_CONV_DIM), SSD_CONV ** -0.5),
        'conv_b': nrm(ks[4], (DEPTH, SSD_CONV_DIM), 0.01),
        'a_log': jnp.log(jax.random.uniform(ks[6], (DEPTH, 2, SSD_HEADS), f32, 1.0, 16.0)),
        'dt_bias': dt0 + jnp.log(-jnp.expm1(-dt0)),
        'd_skip': gain(ks[7], (DEPTH, SSD_HEADS)),
        'ssd_norm_g': gain(ks[8], (DEPTH, SSD_INNER)),
        'q_lat_norm_g': gain(ks[9], (DEPTH, MLA_Q_RANK)),
        'kv_lat_norm_g': gain(ks[10], (DEPTH, MLA_KV_RANK)),
        'w_q_b': nrm(ks[11], (DEPTH, MLA_Q_RANK, MLA_HEADS * (MLA_NOPE + MLA_ROPE)), MLA_Q_RANK ** -0.5),
        'w_kv_b': nrm(ks[12], (DEPTH, MLA_KV_RANK, MLA_HEADS * (MLA_NOPE + MLA_V)), MLA_KV_RANK ** -0.5),
        'w_gate_up': nrm(ks[13], (DEPTH, 2, GLA_GATE_RANK, GLA_HEADS * GLA_DK), GLA_GATE_RANK ** -0.5),
        'b_gate': nrm(ks[14], (DEPTH, 2, GLA_HEADS * GLA_DK), 0.01),
        'gla_norm_g': gain(ks[15], (DEPTH, GLA_WIDTH)),
        'q_norm_g': gain(ks[16], (DEPTH, GQA_HEAD_DIM)),
        'k_norm_g': gain(ks[17], (DEPTH, GQA_HEAD_DIM)),
        'w_br_a': nrm(ks[18], (DEPTH, SSD_INNER, D_MODEL), SSD_INNER ** -0.5),
        'w_br_b': nrm(ks[19], (DEPTH, MLA_WIDTH, D_MODEL), MLA_WIDTH ** -0.5),
        'w_br_c': nrm(ks[20], (DEPTH, GLA_WIDTH, D_MODEL), GLA_WIDTH ** -0.5),
        'w_br_d': nrm(ks[21], (DEPTH, GQA_WIDTH, D_MODEL), GQA_WIDTH ** -0.5),
        'w_out': nrm(ks[22], (DEPTH, D_MODEL, D_MODEL), 0.5 * D_MODEL ** -0.5),
        'final_g': gain(ks[23], (D_MODEL,)),
    }


def reference(x, norm_g, w_in, conv_w, conv_b, a_log, dt_bias, d_skip, ssd_norm_g,
              q_lat_norm_g, kv_lat_norm_g, w_q_b, w_kv_b, w_gate_up, b_gate, gla_norm_g,
              q_norm_g, k_norm_g, w_br_a, w_br_b, w_br_c, w_br_d, w_out, final_g):
    b, L, _ = x.shape
    rows = L // GRID_W
    cos_m, sin_m = axial_rope_tables(rows, MLA_ROPE)
    cos_g, sin_g = axial_rope_tables(rows, GQA_HEAD_DIM)
    split_idx = [int(v) for v in np.cumsum(IN_WIDTHS)[:-1]]
    for i in range(DEPTH):
        h = rmsnorm(x, norm_g[i])
        u = h @ w_in[i]
        (g_merge, z_a, xbc, dt_raw, z_b, q_lat, kv_lat, k_rope, z_c, q_c, k_c, v_c, g_lr,
         z_d, q_d, k_d, v_d) = jnp.split(u, split_idx, axis=-1)
        y_a = ssd_branch(z_a, xbc, dt_raw, conv_w[i], conv_b[i], a_log[i], dt_bias[i], d_skip[i],
                         ssd_norm_g[i], w_br_a[i])
        y_b = mla_branch(z_b, q_lat, kv_lat, k_rope, q_lat_norm_g[i], kv_lat_norm_g[i], w_q_b[i],
                         w_kv_b[i], w_br_b[i], cos_m, sin_m)
        y_c = gla_branch(z_c, q_c, k_c, v_c, g_lr, w_gate_up[i], b_gate[i], gla_norm_g[i], w_br_c[i])
        y_d = gqa_branch(z_d, q_d, k_d, v_d, q_norm_g[i], k_norm_g[i], w_br_d[i], cos_g, sin_g)
        gates = jax.nn.sigmoid(g_merge.astype(jnp.float32)).astype(x.dtype).reshape(b, L, N_BRANCH, D_MODEL)
        mixed = gates[:, :, 0] * y_a + gates[:, :, 1] * y_b + gates[:, :, 2] * y_c + gates[:, :, 3] * y_d
        x = x + mixed @ w_out[i]
    return rmsnorm(x, final_g)
```

```cpp
#include <hip/hip_runtime.h>
#include <hip/hip_cooperative_groups.h>
#include <cstdio>
namespace cg = cooperative_groups;

#define DI __device__ __forceinline__
#define LAS __attribute__((address_space(3)))
typedef unsigned short u16;
typedef short bf16x8 __attribute__((ext_vector_type(8)));
typedef short s16x4 __attribute__((ext_vector_type(4)));
typedef float f32x2 __attribute__((ext_vector_type(2)));
typedef float f32x4 __attribute__((ext_vector_type(4)));
typedef float f32x16 __attribute__((ext_vector_type(16)));
typedef unsigned u32x2 __attribute__((ext_vector_type(2)));
typedef unsigned u32x4 __attribute__((ext_vector_type(4)));
typedef __bf16 bf16x2_t __attribute__((ext_vector_type(2)));

constexpr int T_ALL = 32768, SEQ = 2048, DM = 1024;
constexpr int GSEQ = 4, TG = GSEQ * SEQ, NGROUP = 16 / GSEQ;
constexpr int NIN = 10720, UW = 6656;
constexpr int U_XBC = 0, U_DT = 1536, U_QLAT = 1568, U_KVLAT = 1952, U_KROPE = 2208, U_QD = 2240, U_KD = 2752, U_GLR = 2880,
              U_VD = 2912, U_QC = 3040, U_KC = 3296, U_VC = 3552, U_PAD = 4064, U_ZA = 4096, U_ZB = 5120, U_ZC = 5632, U_ZD = 6144;
DI int ucol_of(int j) {
    if (j < 1024) return U_ZA + j;
    if (j < 2560) return U_XBC + (j - 1024);
    if (j < 2592) return U_DT + (j - 2560);
    if (j < 3104) return U_ZB + (j - 2592);
    if (j < 3488) return U_QLAT + (j - 3104);
    if (j < 3744) return U_KVLAT + (j - 3488);
    if (j < 3776) return U_KROPE + (j - 3744);
    if (j < 4288) return U_ZC + (j - 3776);
    if (j < 4544) return U_QC + (j - 4288);
    if (j < 4800) return U_KC + (j - 4544);
    if (j < 5312) return U_VC + (j - 4800);
    if (j < 5344) return U_GLR + (j - 5312);
    if (j < 5856) return U_ZD + (j - 5344);
    if (j < 6368) return U_QD + (j - 5856);
    if (j < 6496) return U_KD + (j - 6368);
    return U_VD + (j - 6496);
}
constexpr float EPS = 1e-6f;
constexpr float LOG2E = 1.4426950408889634f;

constexpr size_t OFF_WALL = 0;
constexpr size_t OFF_WQ = OFF_WALL + (size_t)10752 * 1024 * 2;
constexpr size_t OFF_WKV = OFF_WQ + (size_t)768 * 384 * 2;
constexpr size_t OFF_WA = OFF_WKV + (size_t)1024 * 256 * 2;
constexpr size_t OFF_WB = OFF_WA + (size_t)1024 * 1024 * 2;
constexpr size_t OFF_WC = OFF_WB + (size_t)1024 * 1024 * 2;
constexpr size_t OFF_WD = OFF_WC + (size_t)1024 * 1024 * 2;
constexpr size_t OFF_WO = OFF_WD + (size_t)1024 * 1024 * 2;
constexpr size_t OFF_HB = OFF_WO + (size_t)1024 * 1024 * 2;
constexpr size_t OFF_AA = OFF_HB + (size_t)T_ALL * 1024 * 2;
constexpr size_t OFF_AB = OFF_AA + (size_t)T_ALL * 1024 * 2;
constexpr size_t OFF_AC = OFF_AB + 512 * 2;
constexpr size_t OFF_AD = OFF_AB + (size_t)T_ALL * 1024 * 2;
constexpr size_t OFF_GRP = OFF_AD + (size_t)T_ALL * 1024 * 2;
constexpr size_t G_U = 0;
constexpr size_t G_DTRAW = G_U + (size_t)TG * UW * 2;
constexpr size_t G_GLR = G_DTRAW + (size_t)TG * 32 * 4;
constexpr size_t G_DTV = G_GLR + (size_t)TG * 32 * 4;
constexpr size_t G_XC = G_DTV + (size_t)TG * 32 * 4;
constexpr size_t G_QM = G_XC + (size_t)TG * 1536 * 2;
constexpr size_t G_KM = G_QM + (size_t)TG * 768 * 2;
constexpr size_t G_VM = G_KM + (size_t)TG * 768 * 2;
constexpr size_t G_QG = G_VM + (size_t)TG * 512 * 2;
constexpr size_t G_KG = G_QG + (size_t)TG * 512 * 2;
constexpr size_t G_YF = G_KG + (size_t)TG * 128 * 2;
constexpr size_t G_YB = G_YF + (size_t)TG * 1024 * 2;
constexpr size_t G_OF = G_YB + (size_t)TG * 1024 * 2;
constexpr size_t G_OB = G_OF + (size_t)TG * 512 * 2;
constexpr size_t G_END = G_OB + (size_t)TG * 512 * 2;
constexpr size_t P5_MIXED = 0;
constexpr size_t P5_SCR = (size_t)T_ALL * 1024 * 2;
constexpr size_t P5_SCR_PER = (size_t)256 * 256 * 2 + (size_t)256 * 256 * 4;
constexpr int MAX_GRID = 256;
static_assert(P5_SCR + MAX_GRID * P5_SCR_PER <= G_END, "p5 scratch must fit the group area");
constexpr size_t OFF_CTR = OFF_GRP + G_END;
constexpr size_t OFF_BAR = OFF_CTR + 4096;
constexpr size_t OFF_GDEC = OFF_BAR + 16384;
constexpr size_t WS_NEED = OFF_GDEC + (size_t)GSEQ * 32 * 4 * 2 * 64 * 4;
static_assert(WS_NEED <= (size_t)536870912, "workspace budget");

constexpr int STAGE_BYTES = 131072;
constexpr int LDS_BYTES = STAGE_BYTES + 2048 + 64;

struct Params {
    const float* in[24];
    float* out; char* ws;
};

DI unsigned pk(float a, float b) { f32x2 v = {a, b}; bf16x2_t r = __builtin_convertvector(v, bf16x2_t); return __builtin_bit_cast(unsigned, r); }
DI u16 f2bf(float a) { return (u16)(pk(a, 0.f) & 0xffffu); }
DI float bflo(unsigned w) { return __uint_as_float(w << 16); }
DI float bfhi(unsigned w) { return __uint_as_float(w & 0xffff0000u); }
DI float bf2f(u16 b) { return __uint_as_float(((unsigned)b) << 16); }
DI float sigmf(float v) { return __builtin_amdgcn_rcpf(1.f + __builtin_amdgcn_exp2f(-v * 1.4426950408889634f)); }
DI float siluf(float v) { return v * sigmf(v); }
DI float softplusf(float v) { return fmaxf(v, 0.f) + log1pf(__expf(-fabsf(v))); }
DI float fexp2(float v) { return __builtin_amdgcn_exp2f(v); }
DI float fexp(float v) { return __builtin_amdgcn_exp2f(v * LOG2E); }
DI int opaque(int v) { asm volatile("" : "+v"(v)); return v; }
DI int crow(int i, int h) { return (i & 3) + 8 * (i >> 2) + 4 * h; }
#define MFMA32(a, b, c) __builtin_amdgcn_mfma_f32_32x32x16_bf16((a), (b), (c), 0, 0, 0)
DI void unpack8(const u32x4 w, float* f) { f[0] = bflo(w.x); f[1] = bfhi(w.x); f[2] = bflo(w.y); f[3] = bfhi(w.y); f[4] = bflo(w.z); f[5] = bfhi(w.z); f[6] = bflo(w.w); f[7] = bfhi(w.w); }
DI u32x4 pack8(const float* f) { u32x4 w; w.x = pk(f[0], f[1]); w.y = pk(f[2], f[3]); w.z = pk(f[4], f[5]); w.w = pk(f[6], f[7]); return w; }
DI void sincos_rope(float ang, float& c, float& s) { const float rev = ang * 0.15915494309189535f; const float fr = rev - floorf(rev); c = __builtin_amdgcn_cosf(fr); s = __builtin_amdgcn_sinf(fr); }
DI f32x16 zero16() { f32x16 z;
#pragma unroll
    for (int i = 0; i < 16; ++i) z[i] = 0.f; return z; }
DI bf16x8 frag_tr(const char* base, int pitch, int k0, int m0, int lane) {
    const int i16 = lane & 15, q = i16 >> 2, p = i16 & 3, blk = (lane >> 4) & 1, h = lane >> 5;
    const char* a = base + (k0 + 8 * h + q) * pitch + (m0 + 16 * blk + 4 * p) * 2;
    const s16x4 lo = __builtin_amdgcn_ds_read_tr16_b64_v4i16((LAS s16x4*)a);
    const s16x4 hi = __builtin_amdgcn_ds_read_tr16_b64_v4i16((LAS s16x4*)(a + 4 * pitch));
    return __builtin_shufflevector(lo, hi, 0, 1, 2, 3, 4, 5, 6, 7);
}
DI bf16x8 lds_frag(const char* p) { return *(const LAS bf16x8*)p; }


#define XB_TMO      128
#define XB_XCNT(j)  (256  + 64 * (j))
#define XB_XSUB(j)  (1280 + 64 * (j))
#define XB_XGEN(j)  (2304 + 64 * (j))
#define XB_TOP      3328
#define XB_TOPGEN   3392
#define XB_SPIN_CAP (1u << 22)
DI unsigned xb_ld(unsigned* p) { return __hip_atomic_load(p, __ATOMIC_RELAXED, __HIP_MEMORY_SCOPE_AGENT); }
DI unsigned xb_add(unsigned* p, unsigned v) { return __hip_atomic_fetch_add(p, v, __ATOMIC_RELAXED, __HIP_MEMORY_SCOPE_AGENT); }
DI unsigned xb_xcc_id() { return (unsigned)__builtin_amdgcn_s_getreg((3 << 11) | 20) & 0xFu; }
#define XB_SPIN(cond, bar) do { unsigned _sp = 0; while (cond) { __builtin_amdgcn_s_sleep(1); \
    if ((++_sp & 255u) == 0u) { if (xb_ld(&(bar)[XB_TMO])) break; if (_sp > XB_SPIN_CAP) { atomicAdd(&(bar)[XB_TMO], 1u); break; } } } } while (0)
struct XcdBarrier { unsigned* bar; unsigned x; volatile LAS unsigned* st; };
DI XcdBarrier xcd_barrier_post(unsigned* bar, volatile LAS unsigned* st) {
    XcdBarrier b; b.bar = bar; b.x = xb_xcc_id(); b.st = st;
    if (threadIdx.x == 0) (void)xb_add(&bar[XB_XCNT(b.x)], 1u);
    return b;
}
DI void xcd_barrier_complete(unsigned* bar, unsigned x, unsigned& nloc, unsigned& nx) {
    const unsigned G = gridDim.x * gridDim.y * gridDim.z;
    unsigned sum, cnt, mine, sp = 0u;
    for (;;) {
        sum = 0u; cnt = 0u; mine = 0u;
#pragma unroll
        for (unsigned j = 0; j < 16; ++j) { const unsigned c = xb_ld(&bar[XB_XCNT(j)]); sum += c; cnt += (c > 0u) ? 1u : 0u; mine = (j == x) ? c : mine; }
        if (sum == G) break;
        __builtin_amdgcn_s_sleep(1);
        if ((++sp & 255u) == 0u) { if (xb_ld(&bar[XB_TMO])) break; if (sp > XB_SPIN_CAP) { atomicAdd(&bar[XB_TMO], 1u); break; } }
    }
    nloc = mine > 0u ? mine : 1u; nx = cnt > 0u ? cnt : 1u;
}
DI void xcd_barrier(const XcdBarrier& b) {
    asm volatile("s_waitcnt vmcnt(0)" ::: "memory");
    __syncthreads();
    if (threadIdx.x == 0) {
        unsigned* bar = b.bar;
        __builtin_amdgcn_s_waitcnt(0);
        unsigned nloc = b.st[0], nx = b.st[1];
        if (nloc == 0u) { xcd_barrier_complete(bar, b.x, nloc, nx); b.st[0] = nloc; b.st[1] = nx; }
        const unsigned old = xb_add(&bar[XB_XSUB(b.x)], 1u);
        const unsigned gen = old / nloc;
        if (old + 1u == (gen + 1u) * nloc) {
            __builtin_amdgcn_fence(__ATOMIC_RELEASE, "agent");
            asm volatile("s_waitcnt vmcnt(0)" ::: "memory");
            const unsigned og = xb_add(&bar[XB_TOP], 1u);
            const unsigned tg = og / nx;
            if (og + 1u == (tg + 1u) * nx) xb_add(&bar[XB_TOPGEN], 1u);
            else XB_SPIN(xb_ld(&bar[XB_TOPGEN]) == tg, bar);
            __builtin_amdgcn_fence(__ATOMIC_ACQUIRE, "agent");
            xb_add(&bar[XB_XGEN(b.x)], 1u);
            asm volatile("s_waitcnt vmcnt(0)" ::: "memory");
        } else {
            XB_SPIN(xb_ld(&bar[XB_XGEN(b.x)]) == gen, bar);
            __builtin_amdgcn_fence(__ATOMIC_ACQUIRE, "agent");
            asm volatile("s_waitcnt vmcnt(0)" ::: "memory");
        }
    }
    __syncthreads();
}

namespace pg8 {
constexpr int BM = 256, BK = 64, HALF = 128, HTB = HALF * BK * 2, NXCD = 8, WGM = 8;
DI int lds_byte(int r, int c) { const int st = (r >> 4) * 2 + (c >> 5), rr = r & 15, cc = c & 31, ob = rr * 64 + cc * 2; return st * 1024 + (ob ^ (((ob >> 9) & 1) << 5)); }
DI void stage_rc(int b, int& R, int& C) { const int st = b / 1024, sb = b % 1024, swz = sb ^ (((sb >> 9) & 1) << 5); R = (st >> 1) * 16 + swz / 64; C = (st & 1) * 32 + (swz % 64) / 2; }
DI int perm32(int rho) { const int n = rho >> 4, i = rho & 15; return 8 * (i >> 2) + 4 * n + (i & 3); }
struct Unit { int pm, pn; const u16* A; const u16* Bt; int nt, tag; };
DI void tile_map(int L, int nM, int nN, Unit& u) {
    const int nwg = nM * nN; int wgid = L;
    { const int q = nwg / NXCD, r = nwg % NXCD, xcd = wgid % NXCD, off = wgid / NXCD; wgid = (xcd < r ? xcd * (q + 1) : r * (q + 1) + (xcd - r) * q) + off; }
    const int nig = WGM * nN, gid = wgid / nig, fm = gid * WGM, gsz = (nM - fm) < WGM ? (nM - fm) : WGM;
    u.pm = fm + ((wgid % nig) % gsz); u.pn = (wgid % nig) / gsz;
}
struct Gemm { const u16* A; int lda; const u16* Bt; int ldb; int K; };
struct Strided { Gemm g; int nM, nN, first, stride, pn0; int lda, ldb;
    DI bool next(int i, Unit& u) const { const int L = first + i * stride; if (L >= nM * nN) return false; tile_map(L, nM, nN, u); u.pn = (pn0 >= 0) ? u.pn + pn0 : ((u.pn < 2 ? 20 : 22) + u.pn);
        u.A = g.A; u.Bt = g.Bt; u.nt = g.K / BK; u.tag = 0; return true; } };
struct OneUnit { Gemm g; int pm, pn; int lda, ldb;
    DI bool next(int i, Unit& u) const { if (i != 0) return false; u.pm = pm; u.pn = pn; u.A = g.A; u.Bt = g.Bt; u.nt = g.K / BK; u.tag = 0; return true; } };

template <class Epi, class Sched>
DI void gemm_phase(LAS unsigned char* lds, const Sched& S, const Epi& E) {
    const int tid = opaque(threadIdx.x), wid = __builtin_amdgcn_readfirstlane(tid >> 6), lane = tid & 63, wr = wid >> 2, wc = wid & 3, fr = lane & 15, fq = lane >> 4;
    const size_t kstep = (size_t)(BK * 2);
    const unsigned ldsw = (unsigned)wid * 1024u;
    const int aoff = lds_byte(wr * 64 + fr, fq * 8), boff = lds_byte(wc * 32 + fr, fq * 8);
#define PG8_SA(b, h) (((b) * 2 + (h)) * HTB)
#define PG8_SB(b, h) ((4 + (b) * 2 + (h)) * HTB)
#define PG8_STAGE(bufoff, gbase, voff) do { _Pragma("unroll") for (int _i = 0; _i < 2; ++_i) \
        __builtin_amdgcn_global_load_lds((const unsigned*)((const char*)(gbase) + (voff)[_i]), (LAS unsigned*)(lds + (bufoff) + ldsw + _i * 8192), 16, 0, 0); } while (0)
#define PG8_LDA(dst, b, h) do { _Pragma("unroll") for (int m = 0; m < 4; ++m) _Pragma("unroll") for (int k = 0; k < 2; ++k) dst[m][k] = *(const LAS bf16x8*)(lds + PG8_SA(b, h) + aoff + m * 2048 + k * 1024); } while (0)
#define PG8_LDB(dst, b, h) do { _Pragma("unroll") for (int n = 0; n < 2; ++n) _Pragma("unroll") for (int k = 0; k < 2; ++k) dst[n][k] = *(const LAS bf16x8*)(lds + PG8_SB(b, h) + boff + n * 2048 + k * 1024); } while (0)
#define PG8_MMA(ai, bj, At, Bt) do { __builtin_amdgcn_s_setprio(1); _Pragma("unroll") for (int m = 0; m < 4; ++m) _Pragma("unroll") for (int n = 0; n < 2; ++n) _Pragma("unroll") for (int k = 0; k < 2; ++k) \
        acc[ai][bj][m][n] = __builtin_amdgcn_mfma_f32_16x16x32_bf16(Bt[n][k], At[m][k], acc[ai][bj][m][n], 0, 0, 0); __builtin_amdgcn_s_setprio(0); } while (0)
#define PG8_WAIT_V(n) asm volatile("s_waitcnt vmcnt(" #n ")" ::: "memory")
#define PG8_WAIT_L(n) asm volatile("s_waitcnt lgkmcnt(" #n ")" ::: "memory")
#define PG8_BAR __builtin_amdgcn_s_barrier()
#define PG8_SCHED __builtin_amdgcn_sched_barrier(0)
    Unit cur, nxt; int ui = 0;
    if (!S.next(0, cur)) return;
    unsigned voffA[2], voffB[2];
#pragma unroll
    for (int i = 0; i < 2; ++i) { int R, C; stage_rc(tid * 16 + i * 8192, R, C); const int Rb = (R & ~31) + perm32(R & 31);
        voffA[i] = (unsigned)(R * S.lda + C) * 2u; voffB[i] = (unsigned)(Rb * S.ldb + C) * 2u; }
    const size_t hstepA = (size_t)HALF * S.lda * 2, hstepB = (size_t)HALF * S.ldb * 2;
    f32x4 acc[2][2][4][2];
#pragma unroll
    for (int a = 0; a < 2; ++a)
#pragma unroll
        for (int b = 0; b < 2; ++b)
#pragma unroll
            for (int m = 0; m < 4; ++m)
#pragma unroll
                for (int n = 0; n < 2; ++n) acc[a][b][m][n] = (f32x4){0.f, 0.f, 0.f, 0.f};
    bf16x8 At[4][2], B0[2][2], B1[2][2];
    const char* cA = (const char*)cur.A + (size_t)cur.pm * 2 * hstepA; const char* cB = (const char*)cur.Bt + (size_t)cur.pn * 2 * hstepB;
    PG8_STAGE(PG8_SB(0, 0), cB, voffB); PG8_STAGE(PG8_SA(0, 0), cA, voffA); PG8_STAGE(PG8_SB(0, 1), cB + hstepB, voffB); PG8_STAGE(PG8_SA(0, 1), cA + hstepA, voffA);
    if (wr == 1) PG8_BAR;
    PG8_WAIT_V(4); PG8_BAR;
    PG8_STAGE(PG8_SB(1, 0), cB + kstep, voffB); PG8_STAGE(PG8_SA(1, 0), cA + kstep, voffA); PG8_STAGE(PG8_SB(1, 1), cB + hstepB + kstep, voffB);
    PG8_WAIT_V(6); PG8_BAR;
    for (;;) {
        const bool has_next = S.next(ui + 1, nxt);
        if (!has_next) nxt = cur;
        const char* nA = (const char*)nxt.A + (size_t)nxt.pm * 2 * hstepA; const char* nB = (const char*)nxt.Bt + (size_t)nxt.pn * 2 * hstepB;
        const int nt = cur.nt;
#pragma unroll 1
        for (int t = 0; t < nt; t += 2) {
            const bool last = (t == nt - 2);
            const char* a1 = cA + (size_t)(t + 1) * kstep;
            const char* a2 = last ? nA : cA + (size_t)(t + 2) * kstep; const char* b2 = last ? nB : cB + (size_t)(t + 2) * kstep;
            const char* a3 = a2 + kstep; const char* b3 = b2 + kstep;
            PG8_LDB(B0, 0, 0); PG8_SCHED; PG8_LDA(At, 0, 0); PG8_STAGE(PG8_SA(1, 1), a1 + hstepA, voffA);
            PG8_WAIT_L(8); PG8_BAR; PG8_WAIT_L(0); PG8_MMA(0, 0, At, B0); PG8_BAR; PG8_SCHED;
            PG8_LDB(B1, 0, 1); PG8_STAGE(PG8_SB(0, 0), b2, voffB);
            PG8_BAR; PG8_WAIT_L(0); PG8_MMA(0, 1, At, B1); PG8_BAR;
            PG8_LDA(At, 0, 1); PG8_STAGE(PG8_SA(0, 0), a2, voffA);
            PG8_BAR; PG8_WAIT_L(0); PG8_MMA(1, 0, At, B0); PG8_BAR; PG8_SCHED;
            PG8_STAGE(PG8_SB(0, 1), b2 + hstepB, voffB);
            PG8_WAIT_V(6); PG8_BAR; PG8_MMA(1, 1, At, B1); PG8_BAR;
            PG8_LDB(B0, 1, 0); PG8_SCHED; PG8_LDA(At, 1, 0); PG8_STAGE(PG8_SA(0, 1), a2 + hstepA, voffA);
            PG8_WAIT_L(8); PG8_BAR; PG8_WAIT_L(0); PG8_MMA(0, 0, At, B0); PG8_BAR; PG8_SCHED;
            PG8_LDB(B1, 1, 1); PG8_STAGE(PG8_SB(1, 0), b3, voffB);
            PG8_BAR; PG8_WAIT_L(0); PG8_MMA(0, 1, At, B1); PG8_BAR;
            PG8_LDA(At, 1, 1); PG8_STAGE(PG8_SA(1, 0), a3, voffA);
            PG8_BAR; PG8_WAIT_L(0); PG8_MMA(1, 0, At, B0); PG8_BAR; PG8_SCHED;
            PG8_STAGE(PG8_SB(1, 1), b3 + hstepB, voffB);
            PG8_WAIT_V(6); PG8_BAR; PG8_MMA(1, 1, At, B1); PG8_BAR;
        }
        E(acc, cur, wr, wc, fr, fq);
        if (!has_next) break;
#pragma unroll
        for (int a = 0; a < 2; ++a)
#pragma unroll
            for (int b = 0; b < 2; ++b)
#pragma unroll
                for (int m = 0; m < 4; ++m)
#pragma unroll
                    for (int n = 0; n < 2; ++n) acc[a][b][m][n] = (f32x4){0.f, 0.f, 0.f, 0.f};
        cur = nxt; cA = nA; cB = nB; ++ui;
    }
    PG8_WAIT_V(0);
    if (wr == 0) PG8_BAR;
    PG8_BAR;
#undef PG8_SA
#undef PG8_SB
#undef PG8_STAGE
#undef PG8_LDA
#undef PG8_LDB
#undef PG8_MMA
#undef PG8_WAIT_V
#undef PG8_WAIT_L
#undef PG8_BAR
#undef PG8_SCHED
}

template <class F> DI void epi_rows(const f32x4 (&acc)[2][2][4][2], const Unit& u, int wr, int wc, int fr, int fq, const F& f) {
    const int row0 = u.pm * BM + wr * 64 + fr, col0 = u.pn * BM + wc * 32 + 8 * fq;
#pragma unroll
    for (int ai = 0; ai < 2; ++ai)
#pragma unroll
        for (int m = 0; m < 4; ++m)
#pragma unroll
            for (int bj = 0; bj < 2; ++bj) f(row0 + ai * HALF + m * 16, col0 + bj * HALF, acc[ai][bj][m][0], acc[ai][bj][m][1]);
}
DI u32x4 pack_v(const f32x4 a, const f32x4 b) { u32x4 w; w.x = pk(a[0], a[1]); w.y = pk(a[2], a[3]); w.z = pk(b[0], b[1]); w.w = pk(b[2], b[3]); return w; }

struct EpiInproj { u16* u; float* dtraw; float* glr;
    DI void operator()(const f32x4 (&acc)[2][2][4][2], const Unit& un, int wr, int wc, int fr_, int fq_) const {
        const int fr = opaque(fr_), fq = opaque(fq_);
        epi_rows(acc, un, wr, wc, fr, fq, [&](int row, int col, f32x4 a, f32x4 b) {
            if (col >= U_ZA) {
#pragma unroll
                for (int j = 0; j < 4; ++j) { a[j] = siluf(a[j]); b[j] = siluf(b[j]); } }
            if (col >= U_DT && col < U_DT + 32) { float* d = dtraw + (size_t)row * 32 + (col - U_DT); *(f32x4*)d = a; *(f32x4*)(d + 4) = b; }
            if (col >= U_GLR && col < U_GLR + 32) { float* d = glr + (size_t)row * 32 + (col - U_GLR); *(f32x4*)d = a; *(f32x4*)(d + 4) = b; }
            *(u32x4*)(u + (size_t)row * UW + col) = pack_v(a, b);
        });
    } };
struct EpiQ { u16* q; const LAS float* rs;
    DI void operator()(const f32x4 (&acc)[2][2][4][2], const Unit& un, int wr, int wc, int fr, int fq) const {
        epi_rows(acc, un, wr, wc, fr, fq, [&](int row, int col, f32x4 a, f32x4 b) {
            const float s = rs[row - un.pm * BM];
            *(u32x4*)(q + (size_t)row * 768 + col) = pack_v(a * s, b * s);
        });
    } };
struct EpiKV { u16* km; u16* vm; const LAS float* rs;
    DI void operator()(const f32x4 (&acc)[2][2][4][2], const Unit& un, int wr, int wc, int fr, int fq) const {
        epi_rows(acc, un, wr, wc, fr, fq, [&](int row, int col, f32x4 a, f32x4 b) {
            const float s = rs[row - un.pm * BM];
            const int head = col >> 7, c = col & 127;
            u16* d = (c < 64) ? (km + (size_t)row * 768 + head * 96 + c) : (vm + (size_t)row * 512 + head * 64 + (c - 64));
            *(u32x4*)d = pack_v(a * s, b * s);
        });
    } };
struct EpiGate { u16* sg;
    DI void operator()(const f32x4 (&acc)[2][2][4][2], const Unit& un, int wr, int wc, int fr, int fq) const {
        epi_rows(acc, un, wr, wc, fr, fq, [&](int row, int col, f32x4 a, f32x4 b) {
#pragma unroll
            for (int j = 0; j < 4; ++j) { a[j] = sigmf(a[j]); b[j] = sigmf(b[j]); }
            *(u32x4*)(sg + (row - un.pm * BM) * 256 + (col - un.pn * BM)) = pack_v(a, b);
        });
    } };
struct EpiBranch { const u16* sg; float* sacc; u16* mixed; int first, last;
    DI void operator()(const f32x4 (&acc)[2][2][4][2], const Unit& un, int wr, int wc, int fr, int fq) const {
        const int lr0 = wr * 64 + fr, lc0 = wc * 32 + 8 * fq;
#pragma unroll
        for (int ai = 0; ai < 2; ++ai) {
            u32x4 gw[4][2], mw[4][2];
#pragma unroll
            for (int m = 0; m < 4; ++m)
#pragma unroll
                for (int bj = 0; bj < 2; ++bj) { const int lr = lr0 + ai * HALF + m * 16, lc = lc0 + bj * HALF;
                    gw[m][bj] = *(const u32x4*)(sg + lr * 256 + lc);
                    mw[m][bj] = first ? (u32x4){0u, 0u, 0u, 0u} : *(const u32x4*)(mixed + (size_t)(un.pm * BM + lr) * 1024 + un.pn * BM + lc); }
#pragma unroll
            for (int m = 0; m < 4; ++m)
#pragma unroll
                for (int bj = 0; bj < 2; ++bj) { const int lr = lr0 + ai * HALF + m * 16, lc = lc0 + bj * HALF;
                    const u32x4 g = gw[m][bj], w = mw[m][bj];
                    f32x4 a = acc[ai][bj][m][0] * (f32x4){bflo(g.x), bfhi(g.x), bflo(g.y), bfhi(g.y)} + (f32x4){bflo(w.x), bfhi(w.x), bflo(w.y), bfhi(w.y)};
                    f32x4 bb = acc[ai][bj][m][1] * (f32x4){bflo(g.z), bfhi(g.z), bflo(g.w), bfhi(g.w)} + (f32x4){bflo(w.z), bfhi(w.z), bflo(w.w), bfhi(w.w)};
                    *(u32x4*)(mixed + (size_t)(un.pm * BM + lr) * 1024 + un.pn * BM + lc) = pack_v(a, bb); }
        }
    } };
struct EpiP5 { u16* sg; float* sacc; u16* mixed;
    DI void operator()(const f32x4 (&acc)[2][2][4][2], const Unit& un, int wr, int wc, int fr_, int fq_) const {
        const int fr = opaque(fr_), fq = opaque(fq_);
        if (un.tag & 1) { EpiBranch e{sg, sacc, mixed, (un.tag >> 1) == 0, (un.tag >> 1) == 3}; e(acc, un, wr, wc, fr, fq); }
        else { EpiGate e{sg}; e(acc, un, wr, wc, fr, fq); }
    } };
struct P5Sched { const char* ws; int first, stride; int lda, ldb;
    DI bool next(int i, Unit& u) const { const int tile = i >> 3, pass = i & 7, br = pass >> 1; const int L = first + tile * stride; if (L >= 512) return false; tile_map(L, 128, 4, u);
        if (pass & 1) { u.A = (const u16*)(ws + (br == 0 ? OFF_AA : br == 1 ? OFF_AB : br == 2 ? OFF_AC : OFF_AD)); u.Bt = (const u16*)(ws + (br == 0 ? OFF_WA : br == 1 ? OFF_WB : br == 2 ? OFF_WC : OFF_WD));
            u.nt = (br == 0 ? 1024 : 512) / BK; }
        else { u.A = (const u16*)(ws + OFF_HB); u.Bt = (const u16*)(ws + OFF_WALL) + (size_t)br * 1024 * 1024; u.nt = 16; }
        u.tag = pass; return true; } };
struct EpiOut { const float* xin; float* out;
    DI void operator()(const f32x4 (&acc)[2][2][4][2], const Unit& un, int wr, int wc, int fr_, int fq_) const {
        const int fr = opaque(fr_), fq = opaque(fq_);
        const int row0 = un.pm * BM + wr * 64 + fr, col0 = un.pn * BM + wc * 32 + 8 * fq;
#pragma unroll
        for (int ai = 0; ai < 2; ++ai) {
            f32x4 x0[4][2], x1[4][2];
#pragma unroll
            for (int m = 0; m < 4; ++m)
#pragma unroll
                for (int bj = 0; bj < 2; ++bj) { const size_t o = (size_t)(row0 + ai * HALF + m * 16) * 1024 + col0 + bj * HALF; x0[m][bj] = __builtin_nontemporal_load((const f32x4*)(xin + o)); x1[m][bj] = __builtin_nontemporal_load((const f32x4*)(xin + o + 4)); }
#pragma unroll
            for (int m = 0; m < 4; ++m)
#pragma unroll
                for (int bj = 0; bj < 2; ++bj) { const size_t o = (size_t)(row0 + ai * HALF + m * 16) * 1024 + col0 + bj * HALF;
                    *(f32x4*)(out + o) = x0[m][bj] + acc[ai][bj][m][0]; *(f32x4*)(out + o + 4) = x1[m][bj] + acc[ai][bj][m][1]; }
        }
    } };
}

template <bool REMAP> DI void wtile(char* shm, const float* src, int ld, int K, int N, u16* dst, int dpitch, const float* scale, int tile) {
    const int tid = opaque(threadIdx.x), lane = tid & 63, wave = __builtin_amdgcn_readfirstlane(tid >> 6);
    float* tl = (float*)(shm + wave * 16640);
    const int nkt = K / 64, kt = tile % nkt, ntile = tile / nkt, k0 = kt * 64, n0 = ntile * 64;
    { const int n = n0 + lane; const bool ok = n < N; const float* sp = src + (size_t)k0 * ld + (ok ? n : 0);
      float v[64];
#pragma unroll
      for (int k = 0; k < 64; ++k) v[k] = sp[(size_t)k * ld];
#pragma unroll
      for (int k = 0; k < 64; ++k) { float x = ok ? v[k] : 0.f; if (scale) x *= scale[k0 + k]; tl[k * 65 + lane] = x; } }
    __builtin_amdgcn_wave_barrier();
    { const int kp = lane & 31, ns = lane >> 5;
#pragma unroll 8
      for (int i = 0; i < 32; ++i) { const int nl = 2 * i + ns, n = n0 + nl; if (n < N) { const int drow = REMAP ? (n < 4096 ? n : 4096 + ucol_of(n - 4096)) : n;
          *(unsigned*)(dst + (size_t)drow * dpitch + k0 + 2 * kp) = pk(tl[(2 * kp) * 65 + nl], tl[(2 * kp + 1) * 65 + nl]); } } }
    __builtin_amdgcn_wave_barrier();
}
DI void phase_weights(char* shm, const Params& p, int layer) {
    char* ws = p.ws;
    if (blockIdx.x == 0) { u32x4* z = (u32x4*)((u16*)(ws + OFF_WALL) + (size_t)(4096 + U_PAD) * 1024); for (int i = opaque(threadIdx.x); i < 32 * 1024 * 2 / 16; i += 512) z[i] = (u32x4){0u, 0u, 0u, 0u}; }
    const int c0 = 16 * 168, c1 = c0 + 6 * 12, c2 = c1 + 4 * 16, c3 = c2 + 256, c4 = c3 + 128, c5 = c4 + 128, c6 = c5 + 128, c7 = c6 + 256;
    const int gw_ = blockIdx.x * 8 + __builtin_amdgcn_readfirstlane(opaque(threadIdx.x) >> 6);
    for (int t = gw_; t < c7; t += gridDim.x * 8) {
        if (t < c0) wtile<true>(shm, p.in[2] + (size_t)layer * 1024 * NIN, NIN, 1024, NIN, (u16*)(ws + OFF_WALL), 1024, nullptr, t);
        else if (t < c1) wtile<false>(shm, p.in[11] + (size_t)layer * 384 * 768, 768, 384, 768, (u16*)(ws + OFF_WQ), 384, p.in[9] + layer * 384, t - c0);
        else if (t < c2) wtile<false>(shm, p.in[12] + (size_t)layer * 256 * 1024, 1024, 256, 1024, (u16*)(ws + OFF_WKV), 256, p.in[10] + layer * 256, t - c1);
        else if (t < c3) wtile<false>(shm, p.in[18] + (size_t)layer * 1024 * 1024, 1024, 1024, 1024, (u16*)(ws + OFF_WA), 1024, nullptr, t - c2);
        else if (t < c4) wtile<false>(shm, p.in[19] + (size_t)layer * 512 * 1024, 1024, 512, 1024, (u16*)(ws + OFF_WB), 1024, nullptr, t - c3);
        else if (t < c5) wtile<false>(shm, p.in[20] + (size_t)layer * 512 * 1024, 1024, 512, 1024, (u16*)(ws + OFF_WC), 1024, nullptr, t - c4);
        else if (t < c6) wtile<false>(shm, p.in[21] + (size_t)layer * 512 * 1024, 1024, 512, 1024, (u16*)(ws + OFF_WD), 1024, nullptr, t - c5);
        else wtile<false>(shm, p.in[22] + (size_t)layer * 1024 * 1024, 1024, 1024, 1024, (u16*)(ws + OFF_WO), 1024, nullptr, t - c6);
    }
}

DI float wave_sum(float v) {
#pragma unroll
    for (int o = 32; o >= 1; o >>= 1) v += __shfl_xor(v, o);
    return v;
}
template <bool FINAL> DI void phase_rownorm(const float* xin, const float* g, u16* hb, float* fout) {
    const int tidx = opaque(threadIdx.x); const int lane = tidx & 63, gw = blockIdx.x * 8 + (tidx >> 6), nw = gridDim.x * 8;
    f32x4 gg[4];
#pragma unroll
    for (int i = 0; i < 4; ++i) gg[i] = ((const f32x4*)g)[lane + 64 * i];
    for (int row = gw; row < T_ALL; row += 2 * nw) {
        const int row1 = row + nw; const bool has1 = row1 < T_ALL;
        const f32x4* xr0 = (const f32x4*)(xin + (size_t)row * 1024); const f32x4* xr1 = (const f32x4*)(xin + (size_t)(has1 ? row1 : row) * 1024);
        f32x4 v0[4], v1[4]; float s0 = 0.f, s1 = 0.f;
#pragma unroll
        for (int i = 0; i < 4; ++i) { v0[i] = __builtin_nontemporal_load(xr0 + lane + 64 * i); v1[i] = __builtin_nontemporal_load(xr1 + lane + 64 * i); }
#pragma unroll
        for (int i = 0; i < 4; ++i) { s0 += v0[i][0] * v0[i][0] + v0[i][1] * v0[i][1] + v0[i][2] * v0[i][2] + v0[i][3] * v0[i][3]; s1 += v1[i][0] * v1[i][0] + v1[i][1] * v1[i][1] + v1[i][2] * v1[i][2] + v1[i][3] * v1[i][3]; }
        s0 = wave_sum(s0); s1 = wave_sum(s1);
        const float r0 = rsqrtf(s0 * (1.f / 1024.f) + EPS), r1 = rsqrtf(s1 * (1.f / 1024.f) + EPS);
#pragma unroll
        for (int i = 0; i < 4; ++i) { const f32x4 o0 = v0[i] * r0 * gg[i], o1 = v1[i] * r1 * gg[i];
            if (FINAL) { ((f32x4*)(fout + (size_t)row * 1024))[lane + 64 * i] = o0; if (has1) ((f32x4*)(fout + (size_t)row1 * 1024))[lane + 64 * i] = o1; }
            else { u32x2 w; w.x = pk(o0[0], o0[1]); w.y = pk(o0[2], o0[3]); *(u32x2*)(hb + (size_t)row * 1024 + 4 * (lane + 64 * i)) = w;
                   if (has1) { w.x = pk(o1[0], o1[1]); w.y = pk(o1[2], o1[3]); *(u32x2*)(hb + (size_t)row1 * 1024 + 4 * (lane + 64 * i)) = w; } } }
    }
}

template <int K> DI void rowstat(char* shm, const u16* A, int lda, int row0) {
    const int tid = opaque(threadIdx.x), r = tid >> 1, half = tid & 1; constexpr int N16 = K / 16;
    const u32x4* src = (const u32x4*)(A + (size_t)(row0 + r) * lda + half * (K / 2));
    u32x4 v[N16];
#pragma unroll
    for (int i = 0; i < N16; ++i) v[i] = src[i];
    float ss = 0.f;
#pragma unroll
    for (int i = 0; i < N16; ++i) { float f[8]; unpack8(v[i], f);
#pragma unroll
        for (int j = 0; j < 8; ++j) ss += f[j] * f[j]; }
    ss += __shfl_xor(ss, 1);
    if (half == 0) ((float*)(shm + STAGE_BYTES))[r] = rsqrtf(ss / (float)K + EPS);
    __syncthreads();
}
DI void conv_task(const Params& p, int layer, char* grp, int task, int lane_in) {
    const int lane = opaque(lane_in);
    const int run = task / 3, chunk = task - run * 3, c = chunk * 512 + lane * 8, t0 = run * 16, pos0 = t0 & (SEQ - 1);
    const u16* u = (const u16*)(grp + G_U); u16* xc = (u16*)(grp + G_XC);
    const float* cw = p.in[3] + (size_t)layer * 5 * 1536 + c; const float* cb = p.in[4] + (size_t)layer * 1536 + c;
    u32x4 rows[20];
#pragma unroll
    for (int i = 0; i < 20; ++i) { const int pp = pos0 - 2 + i; rows[i] = (u32x4){0u, 0u, 0u, 0u};
        if (pp >= 0 && pp < SEQ) rows[i] = __builtin_nontemporal_load((const u32x4*)(u + (size_t)(t0 - 2 + i) * UW + U_XBC + c)); }
    float w[5][8], bias[8];
#pragma unroll
    for (int j = 0; j < 5; ++j) { const f32x4 w0 = *(const f32x4*)(cw + j * 1536), w1 = *(const f32x4*)(cw + j * 1536 + 4);
        w[j][0] = w0[0]; w[j][1] = w0[1]; w[j][2] = w0[2]; w[j][3] = w0[3]; w[j][4] = w1[0]; w[j][5] = w1[1]; w[j][6] = w1[2]; w[j][7] = w1[3]; }
    { const f32x4 b0 = *(const f32x4*)cb, b1 = *(const f32x4*)(cb + 4); bias[0] = b0[0]; bias[1] = b0[1]; bias[2] = b0[2]; bias[3] = b0[3]; bias[4] = b1[0]; bias[5] = b1[1]; bias[6] = b1[2]; bias[7] = b1[3]; }
#pragma unroll
    for (int o = 0; o < 16; ++o) { float acc[8];
#pragma unroll
        for (int e = 0; e < 8; ++e) acc[e] = bias[e];
#pragma unroll
        for (int j = 0; j < 5; ++j) { float f[8]; unpack8(rows[o + j], f);
#pragma unroll
            for (int e = 0; e < 8; ++e) acc[e] += f[e] * w[j][e]; }
#pragma unroll
        for (int e = 0; e < 8; ++e) acc[e] = siluf(acc[e]);
        *(u32x4*)(xc + (size_t)(t0 + o) * 1536 + c) = pack8(acc); }
}
template <int NT> DI void prep_tokens(const Params& p, int layer, char* grp, int tg0, int tstride, int lane_in) {
    const int lane = opaque(lane_in);
    const u16* u = (const u16*)(grp + G_U);
    const int cq = lane, ck = lane & 15, cr = lane & 31;
    u32x4 qraw[NT], kraw[NT]; float xr[NT], dr[NT];
#pragma unroll
    for (int k = 0; k < NT; ++k) { const size_t tg = (size_t)(tg0 + k * tstride);
        qraw[k] = *(const u32x4*)(u + tg * UW + U_QD + cq * 8); kraw[k] = *(const u32x4*)(u + tg * UW + U_KD + ck * 8);
        xr[k] = bf2f(u[tg * UW + U_KROPE + cr]); dr[k] = ((const float*)(grp + G_DTRAW))[tg * 32 + cr]; }
    const float dtb = p.in[6][layer * 32 + cr];
#pragma unroll
    for (int k = 0; k < NT; ++k) { const int tg = tg0 + k * tstride; const int pos = tg & (SEQ - 1);
        const float prow = (float)(pos >> 6), pcol = (float)(pos & 63);
        if (lane < 32) ((float*)(grp + G_DTV))[(size_t)tg * 32 + lane] = softplusf(dr[k] + dtb);
#pragma unroll
        for (int which = 0; which < 2; ++which) {
            const int j = lane & 7;
            const float* gn = (which ? p.in[17] : p.in[16]) + layer * 64;
            float f[8]; unpack8(which ? kraw[k] : qraw[k], f);
            float ss = 0.f;
#pragma unroll
            for (int e = 0; e < 8; ++e) ss += f[e] * f[e];
            ss += __shfl_xor(ss, 1); ss += __shfl_xor(ss, 2); ss += __shfl_xor(ss, 4);
            const float rstd = rsqrtf(ss * (1.f / 64.f) + EPS);
            float o[8];
#pragma unroll
            for (int e = 0; e < 8; ++e) f[e] = f[e] * rstd * gn[8 * j + e];
#pragma unroll
            for (int e = 0; e < 8; ++e) { const float pr = __shfl_xor(f[e], 2); const int col = 8 * j + e, i = col & 31, fi = i & 15;
                const float inv = fexp2(-(float)fi * (13.287712379549449f / 16.f)); float c, s_; sincos_rope(((col >> 5) ? pcol : prow) * inv, c, s_);
                o[e] = f[e] * c + ((i < 16) ? -pr : pr) * s_; }
            if (which == 0) *(u32x4*)((u16*)(grp + G_QG) + (size_t)tg * 512 + lane * 8) = pack8(o);
            else if (lane < 16) *(u32x4*)((u16*)(grp + G_KG) + (size_t)tg * 128 + lane * 8) = pack8(o);
        }
        { const int i = cr; const float x = xr[k]; const float pr = __shfl_xor(x, 8); const int ii = i & 15, fi = ii & 7;
          const float inv = fexp2(-(float)fi * (13.287712379549449f / 8.f)); float c, s_; sincos_rope(((i >> 4) ? pcol : prow) * inv, c, s_);
          const u16 o = f2bf(x * c + ((ii < 8) ? -pr : pr) * s_);
          if (lane < 32) { u16* km = (u16*)(grp + G_KM) + (size_t)tg * 768 + 64 + i;
#pragma unroll
              for (int hh = 0; hh < 8; ++hh) km[hh * 96] = o; } }
    }
}

template <int D, bool MLA>
DI void attn_item(char* shm, const u16* Q, int qpitch, const u16* Kp, int kpitch, const u16* V, int vpitch, const u16* Z, int zpitch, u16* O, int opitch, int tok0, int q0, float scale) {
    constexpr int KCH = D / 8, KP = D * 2 + 16, VP = 144, KBYTES = 64 * KP, VBYTES = 64 * VP, BUF = KBYTES + VBYTES, NKK = D / 16;
    const int tid = opaque(threadIdx.x), lane = tid & 63, wave = __builtin_amdgcn_readfirstlane(tid >> 6), r = lane & 31, h = lane >> 5;
    const int qpos = q0 + wave * 32 + r; const size_t qrow = (size_t)(tok0 + qpos);
    bf16x8 qf[NKK];
    { const float sc = scale * LOG2E;
#pragma unroll
      for (int kk = 0; kk < NKK; ++kk) { float f[8]; unpack8(*(const u32x4*)(Q + qrow * qpitch + 16 * kk + 8 * h), f);
          if (MLA && kk >= 4) { const float pv = (kk == 4) ? (float)(qpos >> 6) : (float)(qpos & 63);
#pragma unroll
              for (int j = 0; j < 8; ++j) { const float pr = __shfl_xor(f[j], 32); const float inv = fexp2(-(float)j * (13.287712379549449f / 8.f)); float c, s; sincos_rope(pv * inv, c, s);
                  f[j] = f[j] * c + (h ? pr : -pr) * s; } }
#pragma unroll
          for (int j = 0; j < 8; ++j) f[j] *= sc;
          qf[kk] = __builtin_bit_cast(bf16x8, pack8(f)); } }
    constexpr int TK = 128, KB2 = TK * KP, VB2 = TK * VP, BUF2 = KB2 + VB2, NKC = (KCH * TK + 511) / 512, NT = SEQ / TK;
    struct AttRegs { u32x4 k[NKC]; u32x4 v[2]; };
    AttRegs RA, RB;
#define ATT_GLOAD(kt, R) do { _Pragma("unroll") for (int c_ = 0; c_ < NKC; ++c_) { const int id_ = tid + 512 * c_; if (id_ < KCH * TK) R.k[c_] = *(const u32x4*)(Kp + (size_t)(tok0 + TK * (kt) + id_ / KCH) * kpitch + (id_ % KCH) * 8); } \
        _Pragma("unroll") for (int c_ = 0; c_ < 2; ++c_) { const int id_ = tid + 512 * c_; R.v[c_] = *(const u32x4*)(V + (size_t)(tok0 + TK * (kt) + (id_ >> 3)) * vpitch + (id_ & 7) * 8); } } while (0)
#define ATT_LSTORE(buf, R) do { char* b_ = shm + (buf) * BUF2; \
        _Pragma("unroll") for (int c_ = 0; c_ < NKC; ++c_) { const int id_ = tid + 512 * c_; if (id_ < KCH * TK) *(LAS u32x4*)(b_ + (id_ / KCH) * KP + (id_ % KCH) * 16) = R.k[c_]; } \
        _Pragma("unroll") for (int c_ = 0; c_ < 2; ++c_) { const int id_ = tid + 512 * c_; *(LAS u32x4*)(b_ + KB2 + (id_ >> 3) * VP + (id_ & 7) * 16) = R.v[c_]; } } while (0)
    f32x16 o0 = zero16(), o1 = zero16(); float mrun = 0.f, lsum = 0.f;
    const int i16 = lane & 15, tq = i16 >> 2, tp = i16 & 3, blk = (lane >> 4) & 1;
    __syncthreads();
    ATT_GLOAD(0, RA); ATT_LSTORE(0, RA); ATT_GLOAD(1, RB);
    __syncthreads();
#define ATT_BODY(kt, RL, RS) do { \
        if ((kt) + 2 < NT) ATT_GLOAD((kt) + 2, RL); \
        const char* kb_ = shm + ((kt) & 1) * BUF2; const char* vb_ = kb_ + KB2; \
        f32x16 sc[4]; \
        { const float nm = -mrun; \
          _Pragma("unroll") for (int q = 0; q < 4; ++q) _Pragma("unroll") for (int i = 0; i < 16; ++i) sc[q][i] = nm; } \
        _Pragma("unroll") for (int kk = 0; kk < NKK; ++kk) _Pragma("unroll") for (int q = 0; q < 4; ++q) sc[q] = MFMA32(lds_frag(kb_ + (32 * q + r) * KP + (16 * kk + 8 * h) * 2), qf[kk], sc[q]); \
        _Pragma("unroll") for (int hf = 0; hf < 2; ++hf) {     \
            float mx = sc[2 * hf][0]; \
            _Pragma("unroll") for (int q = 0; q < 2; ++q) _Pragma("unroll") for (int i = 0; i < 16; ++i) mx = fmaxf(mx, sc[2 * hf + q][i]); \
            mx = fmaxf(mx, __shfl_xor(mx, 32)); \
            const bool need = ((kt) == 0 && hf == 0) || (mx > 8.f); \
            if (__builtin_amdgcn_ballot_w64(need) != 0ull) { \
                const float delta = need ? mx : 0.f, alpha = fexp2(fmaxf(-delta, -126.f)); \
                mrun += delta; lsum *= alpha; \
                _Pragma("unroll") for (int i = 0; i < 16; ++i) { o0[i] *= alpha; o1[i] *= alpha; } \
                _Pragma("unroll") for (int q = 2 * hf; q < 4; ++q) _Pragma("unroll") for (int i = 0; i < 16; ++i) sc[q][i] -= delta; \
            } \
            float ps = 0.f; \
            _Pragma("unroll") for (int q = 0; q < 2; ++q) _Pragma("unroll") for (int i = 0; i < 16; ++i) { sc[2 * hf + q][i] = fexp2(sc[2 * hf + q][i]); ps += sc[2 * hf + q][i]; } \
            lsum += ps; \
            _Pragma("unroll") for (int kq = 0; kq < 2; ++kq) _Pragma("unroll") for (int sp = 0; sp < 2; ++sp) { const int kb = 2 * hf + kq; \
                u32x4 pw; \
                pw.x = pk(sc[kb][8 * sp], sc[kb][8 * sp + 1]); pw.y = pk(sc[kb][8 * sp + 2], sc[kb][8 * sp + 3]); pw.z = pk(sc[kb][8 * sp + 4], sc[kb][8 * sp + 5]); pw.w = pk(sc[kb][8 * sp + 6], sc[kb][8 * sp + 7]); \
                const bf16x8 pf = __builtin_bit_cast(bf16x8, pw); \
                const char* va = vb_ + (32 * kb + 16 * sp + 4 * h + tq) * VP + (16 * blk + 4 * tp) * 2; \
                { const s16x4 lo = __builtin_amdgcn_ds_read_tr16_b64_v4i16((LAS s16x4*)va), hi = __builtin_amdgcn_ds_read_tr16_b64_v4i16((LAS s16x4*)(va + 8 * VP)); \
                  o0 = MFMA32(__builtin_shufflevector(lo, hi, 0, 1, 2, 3, 4, 5, 6, 7), pf, o0); } \
                { const s16x4 lo = __builtin_amdgcn_ds_read_tr16_b64_v4i16((LAS s16x4*)(va + 64)), hi = __builtin_amdgcn_ds_read_tr16_b64_v4i16((LAS s16x4*)(va + 64 + 8 * VP)); \
                  o1 = MFMA32(__builtin_shufflevector(lo, hi, 0, 1, 2, 3, 4, 5, 6, 7), pf, o1); } \
            } \
        } \
        if ((kt) + 1 < NT) ATT_LSTORE(((kt) + 1) & 1, RS); \
        __syncthreads(); } while (0)
#pragma unroll 1
    for (int kt = 0; kt < NT; kt += 2) { ATT_BODY(kt, RA, RB); ATT_BODY(kt + 1, RB, RA); }
#undef ATT_BODY
#undef ATT_GLOAD
#undef ATT_LSTORE
    lsum += __shfl_xor(lsum, 32);
    const float inv = 1.f / lsum;
#pragma unroll
    for (int dvt = 0; dvt < 2; ++dvt)
#pragma unroll
        for (int g4 = 0; g4 < 4; ++g4) { const int dv = 32 * dvt + 8 * g4 + 4 * h;
            const u32x2 zw = *(const u32x2*)(Z + qrow * zpitch + dv);
            float v0, v1, v2, v3;
            if (dvt == 0) { v0 = o0[4 * g4]; v1 = o0[4 * g4 + 1]; v2 = o0[4 * g4 + 2]; v3 = o0[4 * g4 + 3]; } else { v0 = o1[4 * g4]; v1 = o1[4 * g4 + 1]; v2 = o1[4 * g4 + 2]; v3 = o1[4 * g4 + 3]; }
            u32x2 w; w.x = pk(v0 * inv * bflo(zw.x), v1 * inv * bfhi(zw.x)); w.y = pk(v2 * inv * bflo(zw.y), v3 * inv * bfhi(zw.y));
            *(u32x2*)(O + qrow * opitch + dv) = w; }
}

DI void ssd_item(char* shm, const Params& p, int layer, char* grp, int item) {
    const int b = item >> 5, hd = (item >> 1) & 15, dir = item & 1, grpi = hd >> 3, tokbase = b * SEQ;
    const int tid = opaque(threadIdx.x), lane = tid & 63, wave = __builtin_amdgcn_readfirstlane(tid >> 6), r = lane & 31, h = lane >> 5;
    char* cm_ = shm; char* bm_ = shm + 17408; char* xd_ = shm + 34816; char* xdd_ = shm + 44032; char* mm_ = shm + 53248; char* sb_ = shm + 62464;
    float* acum = (float*)(shm + 79872); float* dts = acum + 128; float* eacs = acum + 256;
    const u16* xc = (const u16*)(grp + G_XC); const float* dtv = (const float*)(grp + G_DTV);
    u16* yout = (u16*)(grp + (dir ? G_YB : G_YF));
    const float a_neg = -__expf(p.in[5][layer * 32 + dir * 16 + hd]);
    const int lrow0 = tid >> 4, lch = tid & 15, xrow = tid >> 3, xch = tid & 7;
    struct SsdRegs { u32x4 cm0, cm1, bm0, bm1, xs; float dt; };
    SsdRegs RA, RB; RA.dt = 0.f; RB.dt = 0.f;
#define SSD_TOK(tau) ((size_t)(tokbase + (dir ? SEQ - 1 - (tau) : (tau))))
#define SSD_LOADG(c, R) do { const size_t t0_ = SSD_TOK(64 * (c) + lrow0), t1_ = SSD_TOK(64 * (c) + lrow0 + 32); \
        R.cm0 = *(const u32x4*)(xc + t0_ * 1536 + 1280 + 128 * grpi + lch * 8); R.cm1 = *(const u32x4*)(xc + t1_ * 1536 + 1280 + 128 * grpi + lch * 8); \
        R.bm0 = *(const u32x4*)(xc + t0_ * 1536 + 1024 + 128 * grpi + lch * 8); R.bm1 = *(const u32x4*)(xc + t1_ * 1536 + 1024 + 128 * grpi + lch * 8); \
        R.xs = *(const u32x4*)(xc + SSD_TOK(64 * (c) + xrow) * 1536 + hd * 64 + xch * 8); \
        if (tid < 64) R.dt = dtv[SSD_TOK(64 * (c) + tid) * 32 + dir * 16 + hd]; } while (0)
#define SSD_SCAN(buf, R) do { if (tid < 64) { float v_ = R.dt * a_neg; \
        _Pragma("unroll") for (int o_ = 1; o_ < 64; o_ <<= 1) { const float n_ = __shfl_up(v_, o_); if (lane >= o_) v_ += n_; } \
        dts[(buf) * 64 + tid] = R.dt; acum[(buf) * 64 + tid] = v_; eacs[(buf) * 64 + tid] = fexp(v_); } } while (0)
    __syncthreads();
    for (int i = tid; i < 17408 / 16; i += 512) *(LAS u32x4*)(sb_ + i * 16) = (u32x4){0u, 0u, 0u, 0u};
    SSD_LOADG(0, RA); SSD_LOADG(1, RB); SSD_SCAN(0, RA);
    __syncthreads();
    f32x16 sacc = zero16();
#define SSD_BODY(c, R, RN) do { \
        const float* ac = acum + ((c) & 1) * 64; const float* dcur = dts + ((c) & 1) * 64; const float* eac = eacs + ((c) & 1) * 64; \
        *(LAS u32x4*)(cm_ + lrow0 * 272 + lch * 16) = R.cm0; *(LAS u32x4*)(cm_ + (lrow0 + 32) * 272 + lch * 16) = R.cm1; \
        *(LAS u32x4*)(bm_ + lrow0 * 272 + lch * 16) = R.bm0; *(LAS u32x4*)(bm_ + (lrow0 + 32) * 272 + lch * 16) = R.bm1; \
        { const float d = dcur[xrow], de = fexp(ac[63] - ac[xrow]); float f[8], g[8]; unpack8(R.xs, f); \
          _Pragma("unroll") for (int j = 0; j < 8; ++j) { f[j] *= d; g[j] = f[j] * de; } \
          *(LAS u32x4*)(xd_ + xrow * 144 + xch * 16) = pack8(f); *(LAS u32x4*)(xdd_ + xrow * 144 + xch * 16) = pack8(g); } \
        if ((c) + 2 < 32) SSD_LOADG((c) + 2, R); \
        __syncthreads(); \
        f32x16 y = zero16(); int lt = 0, pt = 0; \
        if (wave < 4) { \
            const int st = wave & 1, lt2 = wave >> 1; f32x16 cb = zero16(); \
            _Pragma("unroll") for (int kk = 0; kk < 8; ++kk) cb = MFMA32(lds_frag(bm_ + (32 * st + r) * 272 + (16 * kk + 8 * h) * 2), lds_frag(cm_ + (32 * lt2 + r) * 272 + (16 * kk + 8 * h) * 2), cb); \
            const int l = 32 * lt2 + r; const float al = ac[l]; \
            _Pragma("unroll") for (int g4 = 0; g4 < 4; ++g4) { const int s0 = 32 * st + 8 * g4 + 4 * h; float v[4]; const f32x4 as4 = *(const LAS f32x4*)(ac + s0); \
                _Pragma("unroll") for (int j = 0; j < 4; ++j) { const int s_ = s0 + j; v[j] = (s_ <= l) ? cb[4 * g4 + j] * fexp(al - as4[j]) : 0.f; } \
                u32x2 w; w.x = pk(v[0], v[1]); w.y = pk(v[2], v[3]); *(LAS u32x2*)(mm_ + l * 144 + s0 * 2) = w; } \
        } else { \
            lt = (wave - 4) >> 1; pt = (wave - 4) & 1; \
            _Pragma("unroll") for (int kk = 0; kk < 8; ++kk) y = MFMA32(lds_frag(cm_ + (32 * lt + r) * 272 + (16 * kk + 8 * h) * 2), lds_frag(sb_ + (32 * pt + r) * 272 + (16 * kk + 8 * h) * 2), y); \
            _Pragma("unroll") for (int g4 = 0; g4 < 4; ++g4) { const f32x4 e4 = *(const LAS f32x4*)(eac + 32 * lt + 8 * g4 + 4 * h); \
                _Pragma("unroll") for (int j = 0; j < 4; ++j) y[4 * g4 + j] *= e4[j]; } \
        } \
        __syncthreads(); \
        if ((c) + 1 < 32) SSD_SCAN(((c) + 1) & 1, RN); \
        if (wave >= 4) { \
            _Pragma("unroll") for (int kk = 0; kk < 4; ++kk) y = MFMA32(lds_frag(mm_ + (32 * lt + r) * 144 + (16 * kk + 8 * h) * 2), frag_tr(xd_, 144, 16 * kk, 32 * pt, lane), y); \
            { const unsigned voff = (unsigned)(((dir ? 4 - 4 * h : 4 * h) * 1024 + r) * 2); const int tb = dir ? (SEQ - 1 - 64 * (c) - 32 * lt - 4) : (64 * (c) + 32 * lt); \
              _Pragma("unroll") for (int i = 0; i < 16; ++i) { const int k_ = (i & 3) + 8 * (i >> 2); const int trow = dir ? tb - k_ : tb + k_; \
                char* ub = (char*)(yout + (size_t)(tokbase + trow) * 1024 + hd * 64 + 32 * pt); *(u16*)(ub + voff) = f2bf(y[i]); } } \
        } \
        { \
            const int nt = wave >> 1, pt2 = wave & 1; const float cd = fexp(ac[63]); \
            _Pragma("unroll") for (int i = 0; i < 16; ++i) sacc[i] *= cd; \
            _Pragma("unroll") for (int kk = 0; kk < 4; ++kk) sacc = MFMA32(frag_tr(bm_, 272, 16 * kk, 32 * nt, lane), frag_tr(xdd_, 144, 16 * kk, 32 * pt2, lane), sacc); \
            const int pp = 32 * pt2 + r; \
            _Pragma("unroll") for (int g4 = 0; g4 < 4; ++g4) { u32x2 w; w.x = pk(sacc[4 * g4], sacc[4 * g4 + 1]); w.y = pk(sacc[4 * g4 + 2], sacc[4 * g4 + 3]); \
                *(LAS u32x2*)(sb_ + pp * 272 + (32 * nt + 8 * g4 + 4 * h) * 2) = w; } \
        } \
        __syncthreads(); } while (0)
#pragma unroll 1
    for (int c = 0; c < 32; c += 2) { SSD_BODY(c, RA, RB); SSD_BODY(c + 1, RB, RA); }
#undef SSD_BODY
#undef SSD_TOK
#undef SSD_LOADG
#undef SSD_SCAN
}

DI u16* gla_img(char* ws, int which) { return (u16*)(ws + OFF_AD) + 512 + (size_t)which * TG * 1024; }
DI void gla_prep_task(char* shm, const Params& p, int layer, char* grp, int task) {
    const int b = task >> 8, c = (task >> 3) & 31, hd = (task >> 1) & 3, dir = task & 1, tokbase = b * SEQ;
    const int tid = opaque(threadIdx.x), kc = tid & 63, sg = tid >> 6, lrow0 = tid >> 4, lrr = tid & 15;
    float* gl_ = (float*)shm; float* seg_ = gl_ + 1024;
    const u16* u = (const u16*)(grp + G_U); const float* glr = (const float*)(grp + G_GLR);
#define GLA_TOK(tau) ((size_t)(tokbase + (dir ? SEQ - 1 - (tau) : (tau))))
    __syncthreads();
    gl_[tid] = glr[GLA_TOK(64 * c + lrow0) * 32 + dir * 16 + lrr]; gl_[tid + 512] = glr[GLA_TOK(64 * c + lrow0 + 32) * 32 + dir * 16 + lrr];
    float wreg[16]; float bgk;
    { const float* wg = p.in[13] + ((size_t)(layer * 2 + dir) * 16) * 256 + hd * 64;
#pragma unroll
      for (int rr = 0; rr < 16; ++rr) wreg[rr] = wg[rr * 256 + kc];
      bgk = p.in[14][(layer * 2 + dir) * 256 + hd * 64 + kc]; }
    u16 qv[8], kv[8];
#pragma unroll
    for (int i = 0; i < 8; ++i) { const size_t t = GLA_TOK(64 * c + 8 * sg + i); qv[i] = u[t * UW + U_QC + hd * 64 + kc]; kv[i] = u[t * UW + U_KC + hd * 64 + kc]; }
    __syncthreads();
    float gc[8]; float run = 0.f;
#pragma unroll
    for (int i = 0; i < 8; ++i) { const int l = 8 * sg + i; float pre = bgk;
#pragma unroll
        for (int q4 = 0; q4 < 4; ++q4) { const f32x4 gv = *(const LAS f32x4*)(gl_ + l * 16 + 4 * q4); pre += gv[0] * wreg[4 * q4] + gv[1] * wreg[4 * q4 + 1] + gv[2] * wreg[4 * q4 + 2] + gv[3] * wreg[4 * q4 + 3]; }
        const float lg = (fminf(pre, 0.f) - 0.6931471805599453f * __builtin_amdgcn_logf(1.f + fexp(-fabsf(pre)))) * (1.f / 16.f); run += lg; gc[i] = run; }
    seg_[sg * 64 + kc] = run;
    __syncthreads();
    float off = 0.f, tot = 0.f;
#pragma unroll
    for (int s2 = 0; s2 < 8; ++s2) { const float v = seg_[s2 * 64 + kc]; tot += v; if (s2 < sg) off += v; }
    u16* qg = gla_img(p.ws, 0); u16* kg = gla_img(p.ws, 1); u16* ke = gla_img(p.ws, 2);
#pragma unroll
    for (int i = 0; i < 8; ++i) { const float g = gc[i] + off; const float qf_ = bf2f(qv[i]), kf_ = bf2f(kv[i]);
        const size_t o = GLA_TOK(64 * c + 8 * sg + i) * 1024 + dir * 256 + hd * 64 + kc;
        qg[o] = f2bf(qf_ * 0.125f * fexp(g)); kg[o] = f2bf(kf_ * fexp(-g)); ke[o] = f2bf(kf_ * fexp(tot - g)); }
    if (sg == 0) ((float*)(p.ws + OFF_GDEC))[(size_t)task * 64 + kc] = fexp(tot);
#undef GLA_TOK
}
DI void gla_item(char* shm, const Params& p, int layer, char* grp, int item) {
    const int b = item >> 3, hd = (item >> 1) & 3, dir = item & 1, tokbase = b * SEQ;
    const int tid = opaque(threadIdx.x), lane = tid & 63, wave = __builtin_amdgcn_readfirstlane(tid >> 6), r = lane & 31, h = lane >> 5;
    char* qg_ = shm; char* kg_ = shm + 9216; char* ke_ = shm + 18432; char* v_ = shm + 27648; char* att_ = shm + 45056; char* sbt_ = shm + 54272;
    float* g63_ = (float*)(shm + 72704);
    const u16* u = (const u16*)(grp + G_U);
    const u16* qgi = gla_img(p.ws, 0) + dir * 256 + hd * 64; const u16* kgi = gla_img(p.ws, 1) + dir * 256 + hd * 64; const u16* kei = gla_img(p.ws, 2) + dir * 256 + hd * 64;
    const float* gdec = (const float*)(p.ws + OFF_GDEC);
    u16* oout = (u16*)(grp + (dir ? G_OB : G_OF));
    const int lrow0 = tid >> 4, lrr = tid & 15, xrow = tid >> 3, xch = tid & 7;
    struct GlaRegs { u32x4 v0, v1, qg, kg, ke; float dec; };
    GlaRegs RA, RB; RA.dec = 0.f; RB.dec = 0.f;
#define GLA_TOK(tau) ((size_t)(tokbase + (dir ? SEQ - 1 - (tau) : (tau))))
#define GLA_LOADG(c, R) do { const size_t t0_ = GLA_TOK(64 * (c) + lrow0), t1_ = GLA_TOK(64 * (c) + lrow0 + 32), tx_ = GLA_TOK(64 * (c) + xrow); \
        R.v0 = *(const u32x4*)(u + t0_ * UW + U_VC + hd * 128 + lrr * 8); R.v1 = *(const u32x4*)(u + t1_ * UW + U_VC + hd * 128 + lrr * 8); \
        R.qg = *(const u32x4*)(qgi + tx_ * 1024 + xch * 8); R.kg = *(const u32x4*)(kgi + tx_ * 1024 + xch * 8); R.ke = *(const u32x4*)(kei + tx_ * 1024 + xch * 8); \
        if (tid < 64) R.dec = gdec[(size_t)((((b * 32 + (c)) * 4 + hd) * 2) + dir) * 64 + tid]; } while (0)
    __syncthreads();
    for (int i = tid; i < 18432 / 16; i += 512) *(LAS u32x4*)(sbt_ + i * 16) = (u32x4){0u, 0u, 0u, 0u};
    GLA_LOADG(0, RA); GLA_LOADG(1, RB);
    f32x16 sacc = zero16();
#define GLA_BODY(c, R) do { \
        *(LAS u32x4*)(v_ + lrow0 * 272 + lrr * 16) = R.v0; *(LAS u32x4*)(v_ + (lrow0 + 32) * 272 + lrr * 16) = R.v1; \
        *(LAS u32x4*)(qg_ + xrow * 144 + xch * 16) = R.qg; *(LAS u32x4*)(kg_ + xrow * 144 + xch * 16) = R.kg; *(LAS u32x4*)(ke_ + xrow * 144 + xch * 16) = R.ke; \
        if (tid < 64) g63_[tid] = R.dec; \
        if ((c) + 2 < 32) GLA_LOADG((c) + 2, R); \
        __syncthreads(); \
        if (wave < 4) { \
            const int st = wave & 1, lt2 = wave >> 1; f32x16 at = zero16(); \
            _Pragma("unroll") for (int kk = 0; kk < 4; ++kk) at = MFMA32(lds_frag(kg_ + (32 * st + r) * 144 + (16 * kk + 8 * h) * 2), lds_frag(qg_ + (32 * lt2 + r) * 144 + (16 * kk + 8 * h) * 2), at); \
            const int l = 32 * lt2 + r; \
            _Pragma("unroll") for (int g4 = 0; g4 < 4; ++g4) { const int s0 = 32 * st + 8 * g4 + 4 * h; float v[4]; \
                _Pragma("unroll") for (int j = 0; j < 4; ++j) v[j] = (s0 + j <= l) ? at[4 * g4 + j] : 0.f; \
                u32x2 w; w.x = pk(v[0], v[1]); w.y = pk(v[2], v[3]); *(LAS u32x2*)(att_ + l * 144 + s0 * 2) = w; } \
        } \
        const int lt = wave >> 2, vt = wave & 3; \
        f32x16 o = zero16(); \
        _Pragma("unroll") for (int kk = 0; kk < 4; ++kk) o = MFMA32(lds_frag(qg_ + (32 * lt + r) * 144 + (16 * kk + 8 * h) * 2), lds_frag(sbt_ + (32 * vt + r) * 144 + (16 * kk + 8 * h) * 2), o); \
        __syncthreads(); \
        _Pragma("unroll") for (int kk = 0; kk < 4; ++kk) o = MFMA32(lds_frag(att_ + (32 * lt + r) * 144 + (16 * kk + 8 * h) * 2), frag_tr(v_, 272, 16 * kk, 32 * vt, lane), o); \
        { const unsigned voff = (unsigned)(((dir ? 4 - 4 * h : 4 * h) * 512 + r) * 2); const int tb = dir ? (SEQ - 1 - 64 * (c) - 32 * lt - 4) : (64 * (c) + 32 * lt); \
          _Pragma("unroll") for (int i = 0; i < 16; ++i) { const int k_ = (i & 3) + 8 * (i >> 2); const int trow = dir ? tb - k_ : tb + k_; \
            char* ub = (char*)(oout + (size_t)(tokbase + trow) * 512 + hd * 128 + 32 * vt); *(u16*)(ub + voff) = f2bf(o[i]); } } \
        { \
            const int kt = lt; \
            _Pragma("unroll") for (int i = 0; i < 16; ++i) sacc[i] *= g63_[32 * kt + crow(i, h)]; \
            _Pragma("unroll") for (int kk = 0; kk < 4; ++kk) sacc = MFMA32(frag_tr(ke_, 144, 16 * kk, 32 * kt, lane), frag_tr(v_, 272, 16 * kk, 32 * vt, lane), sacc); \
            const int vv = 32 * vt + r; \
            _Pragma("unroll") for (int g4 = 0; g4 < 4; ++g4) { u32x2 w; w.x = pk(sacc[4 * g4], sacc[4 * g4 + 1]); w.y = pk(sacc[4 * g4 + 2], sacc[4 * g4 + 3]); \
                *(LAS u32x2*)(sbt_ + vv * 144 + (32 * kt + 8 * g4 + 4 * h) * 2) = w; } \
        } \
        __syncthreads(); } while (0)
#pragma unroll 1
    for (int c = 0; c < 32; c += 2) { GLA_BODY(c, RA); GLA_BODY(c + 1, RB); }
#undef GLA_BODY
#undef GLA_TOK
#undef GLA_LOADG
}

DI void post_token(const Params& p, int layer, char* grp, int g, int tg, int lane_in) {
    const int lane = opaque(lane_in);
    const u16* u = (const u16*)(grp + G_U);
    const size_t tglob = (size_t)g * TG + tg;
    { const u16* yf = (const u16*)(grp + G_YF); const u16* yb = (const u16*)(grp + G_YB); const u16* xc = (const u16*)(grp + G_XC);
      u16* aa = (u16*)(p.ws + OFF_AA); const float* ng = p.in[8] + layer * 1024; const float* ds = p.in[7] + layer * 16;
      float v[2][8]; float ss = 0.f;
#pragma unroll
      for (int i = 0; i < 2; ++i) { const int c = lane * 8 + 512 * i; float a[8], bb[8], x[8], z[8];
          unpack8(__builtin_nontemporal_load((const u32x4*)(yf + (size_t)tg * 1024 + c)), a); unpack8(__builtin_nontemporal_load((const u32x4*)(yb + (size_t)tg * 1024 + c)), bb);
          unpack8(*(const u32x4*)(xc + (size_t)tg * 1536 + c), x); unpack8(*(const u32x4*)(u + (size_t)tg * UW + U_ZA + c), z);
          const float dsk = ds[c >> 6];
#pragma unroll
          for (int j = 0; j < 8; ++j) { v[i][j] = (a[j] + bb[j] + x[j] * dsk) * z[j]; ss += v[i][j] * v[i][j]; } }
      ss = wave_sum(ss); const float rstd = rsqrtf(ss * (1.f / 1024.f) + EPS);
#pragma unroll
      for (int i = 0; i < 2; ++i) { const int c = lane * 8 + 512 * i; float o[8];
#pragma unroll
          for (int j = 0; j < 8; ++j) o[j] = v[i][j] * rstd * ng[c + j];
          *(u32x4*)(aa + tglob * 1024 + c) = pack8(o); } }
    { const u16* of = (const u16*)(grp + G_OF); const u16* ob = (const u16*)(grp + G_OB); u16* ac = (u16*)(p.ws + OFF_AC); const float* ng = p.in[15] + layer * 512;
      const int c = lane * 8; float a[8], bb[8], z[8], o[8]; float ss = 0.f;
      unpack8(__builtin_nontemporal_load((const u32x4*)(of + (size_t)tg * 512 + c)), a); unpack8(__builtin_nontemporal_load((const u32x4*)(ob + (size_t)tg * 512 + c)), bb); unpack8(*(const u32x4*)(u + (size_t)tg * UW + U_ZC + c), z);
#pragma unroll
      for (int j = 0; j < 8; ++j) { a[j] += bb[j]; ss += a[j] * a[j]; }
      ss += __shfl_xor(ss, 1); ss += __shfl_xor(ss, 2); ss += __shfl_xor(ss, 4); ss += __shfl_xor(ss, 8);
      const float rstd = rsqrtf(ss * (1.f / 128.f) + EPS);
#pragma unroll
      for (int j = 0; j < 8; ++j) o[j] = a[j] * rstd * ng[c + j] * z[j];
      *(u32x4*)(ac + tglob * 1024 + c) = pack8(o); }
}

__global__ void __launch_bounds__(512) mega(Params p) {
    extern __shared__ __attribute__((aligned(16))) char shm[];
    cg::grid_group grid = cg::this_grid();
    LAS unsigned char* lds = (LAS unsigned char*)shm;
    const int G = gridDim.x, bx = blockIdx.x;
    char* ws = p.ws; char* grp = ws + OFF_GRP;
    volatile LAS unsigned* xst = (volatile LAS unsigned*)(lds + STAGE_BYTES + 2048);
    if (threadIdx.x == 0) { xst[0] = 0u; xst[1] = 0u; }
    __syncthreads();
    const XcdBarrier xbar = xcd_barrier_post((unsigned*)(ws + OFF_BAR), xst);
#define GSYNC() xcd_barrier(xbar)
#pragma unroll 1
    for (int layer = 0; layer < 2; ++layer) {
        const float* xin = layer == 0 ? p.in[0] : p.out;
        phase_weights(shm, p, layer);
        phase_rownorm<false>(xin, p.in[1] + layer * 1024, (u16*)(ws + OFF_HB), nullptr);
        if (p.out == nullptr) grid.sync();
        GSYNC();
#pragma unroll 1
        for (int g = 0; g < NGROUP; ++g) {
            { pg8::Gemm gm{(const u16*)(ws + OFF_HB) + (size_t)g * TG * 1024, 1024, (const u16*)(ws + OFF_WALL) + (size_t)4096 * 1024, 1024, 1024};
              pg8::Strided S{gm, TG / 256, 16, bx, G, 0, gm.lda, gm.ldb};
              pg8::EpiInproj E{(u16*)(grp + G_U), (float*)(grp + G_DTRAW), (float*)(grp + G_GLR)};
              pg8::gemm_phase(lds, S, E); }
            GSYNC();
            { { pg8::Gemm gm{(const u16*)(ws + OFF_HB) + (size_t)g * TG * 1024, 1024, (const u16*)(ws + OFF_WALL) + (size_t)4096 * 1024, 1024, 1024};
                pg8::Strided S{gm, TG / 256, 4, bx, G, -1, gm.lda, gm.ldb};
                pg8::EpiInproj E{(u16*)(grp + G_U), (float*)(grp + G_DTRAW), (float*)(grp + G_GLR)};
                pg8::gemm_phase(lds, S, E); }
              unsigned* ctr = (unsigned*)(ws + OFF_CTR) + 16 + layer * 4 + g; volatile int* slot = (volatile int*)(shm + STAGE_BYTES + 2064);
              const int ngla = GSEQ * 32 * 4 * 2, nq = 32 * 3, nkv = 32 * 4, nconv = (TG / 16) * 3 / 8, ntok = TG / 32;
#pragma unroll 1
              for (;;) {
                __syncthreads();
                if (threadIdx.x == 0) *slot = (int)atomicAdd(ctr, 1u);
                __syncthreads();
                const int it0 = __builtin_amdgcn_readfirstlane(*slot);
                if (it0 >= ngla + nq + nkv + nconv + ntok) break;
                if (it0 < ngla) { gla_prep_task(shm, p, layer, grp, it0); continue; }
                const int it = it0 - ngla;
                if (it < nq) { const int pm = it / 3, pn = it % 3; rowstat<384>(shm, (const u16*)(grp + G_U) + U_QLAT, UW, pm * 256);
                  pg8::Gemm gm{(const u16*)(grp + G_U) + U_QLAT, UW, (const u16*)(ws + OFF_WQ), 384, 384}; pg8::OneUnit S{gm, pm, pn, gm.lda, gm.ldb};
                  pg8::EpiQ E{(u16*)(grp + G_QM), (const LAS float*)(shm + STAGE_BYTES)}; pg8::gemm_phase(lds, S, E); }
                else if (it < nq + nkv) { const int t = it - nq, pm = t >> 2, pn = t & 3; rowstat<256>(shm, (const u16*)(grp + G_U) + U_KVLAT, UW, pm * 256);
                  pg8::Gemm gm{(const u16*)(grp + G_U) + U_KVLAT, UW, (const u16*)(ws + OFF_WKV), 256, 256}; pg8::OneUnit S{gm, pm, pn, gm.lda, gm.ldb};
                  pg8::EpiKV E{(u16*)(grp + G_KM), (u16*)(grp + G_VM), (const LAS float*)(shm + STAGE_BYTES)}; pg8::gemm_phase(lds, S, E); }
                else { const int t_ = opaque(threadIdx.x); const int wave = __builtin_amdgcn_readfirstlane(t_ >> 6);
                  if (it < nq + nkv + nconv) conv_task(p, layer, grp, (it - nq - nkv) * 8 + wave, t_ & 63);
                  else prep_tokens<4>(p, layer, grp, (it - nq - nkv - nconv) * 32 + wave * 4, 1, t_ & 63); }
              } }
            GSYNC();
            { unsigned* ctr = (unsigned*)(ws + OFF_CTR) + layer * 4 + g; volatile int* slot = (volatile int*)(shm + STAGE_BYTES + 2064);
#pragma unroll 1
              for (;;) {
                __syncthreads();
                if (threadIdx.x == 0) *slot = (int)atomicAdd(ctr, 1u);
                __syncthreads();
                const int it = __builtin_amdgcn_readfirstlane(*slot);
                if (it >= 32 + 128 + 256 + 256 + 192) break;
                if (it < 32) gla_item(shm, p, layer, grp, it);
                else if (it < 160) ssd_item(shm, p, layer, grp, it - 32);
                else if (it < 416) { const int a = it - 160, b = a >> 6, hd = (a >> 3) & 7, qb = a & 7;
                    attn_item<96, true>(shm, (const u16*)(grp + G_QM) + hd * 96, 768, (const u16*)(grp + G_KM) + hd * 96, 768, (const u16*)(grp + G_VM) + hd * 64, 512,
                                        (const u16*)(grp + G_U) + U_ZB + hd * 64, UW, (u16*)(ws + OFF_AB) + (size_t)g * TG * 1024 + hd * 64, 1024, b * SEQ, qb * 256, 0.10206207261596577f); }
                else if (it >= 672) { const int zi = it - 672, pm = zi / 6, pl = zi % 6, pn = (pl < 4) ? 16 + pl : 18 + pl;
                    pg8::Gemm gm{(const u16*)(ws + OFF_HB) + (size_t)g * TG * 1024, 1024, (const u16*)(ws + OFF_WALL) + (size_t)4096 * 1024, 1024, 1024};
                    pg8::OneUnit S{gm, pm, pn, gm.lda, gm.ldb}; pg8::EpiInproj E{(u16*)(grp + G_U), (float*)(grp + G_DTRAW), (float*)(grp + G_GLR)};
                    pg8::gemm_phase(lds, S, E); }
                else { const int a = it - 416, b = a >> 6, hd = (a >> 3) & 7, qb = a & 7, kvh = hd >> 2;
                    attn_item<64, false>(shm, (const u16*)(grp + G_QG) + hd * 64, 512, (const u16*)(grp + G_KG) + kvh * 64, 128, (const u16*)(grp + G_U) + U_VD + kvh * 64, UW,
                                         (const u16*)(grp + G_U) + U_ZD + hd * 64, UW, (u16*)(ws + OFF_AD) + (size_t)g * TG * 1024 + hd * 64, 1024, b * SEQ, qb * 256, 0.125f); }
              } }
            GSYNC();
            { const int t_ = opaque(threadIdx.x); const int wave = __builtin_amdgcn_readfirstlane(t_ >> 6);
                for (int tg = bx * 8 + wave; tg < TG; tg += G * 8) post_token(p, layer, grp, g, tg, t_ & 63); }
            if (g == NGROUP - 1) GSYNC();
        }
        { u16* sgp = (u16*)(grp + P5_SCR + (size_t)bx * P5_SCR_PER); float* saccp = (float*)(grp + P5_SCR + (size_t)bx * P5_SCR_PER + 256 * 256 * 2);
          pg8::P5Sched S{ws, bx, G, 1024, 1024}; pg8::EpiP5 E{sgp, saccp, (u16*)(grp + P5_MIXED)};
          pg8::gemm_phase(lds, S, E); }
        GSYNC();
        { pg8::Gemm gm{(const u16*)(grp + P5_MIXED), 1024, (const u16*)(ws + OFF_WO), 1024, 1024}; pg8::Strided S{gm, 128, 4, bx, G, 0, gm.lda, gm.ldb};
          pg8::EpiOut E{xin, p.out}; pg8::gemm_phase(lds, S, E); }
        GSYNC();
    }
    phase_rownorm<true>(p.out, p.in[23], nullptr, p.out);
}

extern "C" void kernel_launch(void* const* d_in, const int* in_sizes, int n_in, void* d_out, int out_size, void* d_ws, size_t ws_size, hipStream_t stream) {
    static int grid_blocks = 0;
    if (grid_blocks == 0) {
        if (n_in != 24 || ws_size < WS_NEED) { fprintf(stderr, "kernel_launch: need 24 inputs and %zu bytes of workspace, got %d / %zu\n", (size_t)WS_NEED, n_in, ws_size); grid_blocks = -1; return; }
        int dev = 0, cus = 0, per_cu = 0;
        hipGetDevice(&dev);
        hipDeviceGetAttribute(&cus, hipDeviceAttributeMultiprocessorCount, dev);
        if (hipFuncSetAttribute((const void*)mega, hipFuncAttributeMaxDynamicSharedMemorySize, LDS_BYTES) != hipSuccess) { fprintf(stderr, "kernel_launch: hipFuncSetAttribute failed\n"); grid_blocks = -1; return; }
        hipOccupancyMaxActiveBlocksPerMultiprocessor(&per_cu, (const void*)mega, 512, LDS_BYTES);
        if (per_cu < 1) { fprintf(stderr, "kernel_launch: occupancy query says 0 blocks per CU\n"); per_cu = 1; }
        grid_blocks = cus * per_cu;
        if (grid_blocks > MAX_GRID) grid_blocks = MAX_GRID;
        grid_blocks &= ~7;
    }
    if (grid_blocks <= 0) return;
    if (hipMemsetAsync((char*)d_ws + OFF_CTR, 0, 4096 + 16384, stream) != hipSuccess) { fprintf(stderr, "kernel_launch: memset failed\n"); return; }
    Params p{};
    for (int i = 0; i < 24; ++i) p.in[i] = (const float*)d_in[i];
    p.out = (float*)d_out; p.ws = (char*)d_ws;
    void* args[] = {&p};
    hipError_t e = hipLaunchCooperativeKernel((const void*)mega, dim3(grid_blocks), dim3(512), args, LDS_BYTES, stream);
    if (e != hipSuccess) fprintf(stderr, "cooperative launch failed: %s (grid %d)\n", hipGetErrorString(e), grid_blocks);
}
```

```cpp
#include <hip/hip_runtime.h>
#include <hip/hip_cooperative_groups.h>
#include <cstdio>
namespace cg = cooperative_groups;

#define DI __device__ __forceinline__
#define LAS __attribute__((address_space(3)))
typedef unsigned short u16;
typedef short bf16x8 __attribute__((ext_vector_type(8)));
typedef short s16x4 __attribute__((ext_vector_type(4)));
typedef float f32x2 __attribute__((ext_vector_type(2)));
typedef float f32x4 __attribute__((ext_vector_type(4)));
typedef float f32x16 __attribute__((ext_vector_type(16)));
typedef unsigned u32x2 __attribute__((ext_vector_type(2)));
typedef unsigned u32x4 __attribute__((ext_vector_type(4)));
typedef __bf16 bf16x2_t __attribute__((ext_vector_type(2)));

constexpr int T_ALL = 32768, SEQ = 2048, DM = 1024;
constexpr int GSEQ = 4, TG = GSEQ * SEQ, NGROUP = 16 / GSEQ;
constexpr int NIN = 10720, UW = 6656;
constexpr int U_XBC = 0, U_DT = 1536, U_QLAT = 1568, U_KVLAT = 1952, U_KROPE = 2208, U_QD = 2240, U_KD = 2752, U_GLR = 2880,
              U_VD = 2912, U_QC = 3040, U_KC = 3296, U_VC = 3552, U_PAD = 4064, U_ZA = 4096, U_ZB = 5120, U_ZC = 5632, U_ZD = 6144;
DI int ucol_of(int j) {
    if (j < 1024) return U_ZA + j;
    if (j < 2560) return U_XBC + (j - 1024);
    if (j < 2592) return U_DT + (j - 2560);
    if (j < 3104) return U_ZB + (j - 2592);
    if (j < 3488) return U_QLAT + (j - 3104);
    if (j < 3744) return U_KVLAT + (j - 3488);
    if (j < 3776) return U_KROPE + (j - 3744);
    if (j < 4288) return U_ZC + (j - 3776);
    if (j < 4544) return U_QC + (j - 4288);
    if (j < 4800) return U_KC + (j - 4544);
    if (j < 5312) return U_VC + (j - 4800);
    if (j < 5344) return U_GLR + (j - 5312);
    if (j < 5856) return U_ZD + (j - 5344);
    if (j < 6368) return U_QD + (j - 5856);
    if (j < 6496) return U_KD + (j - 6368);
    return U_VD + (j - 6496);
}
constexpr float EPS = 1e-6f;
constexpr float LOG2E = 1.4426950408889634f;

constexpr size_t OFF_WALL = 0;
constexpr size_t OFF_WQ = OFF_WALL + (size_t)10752 * 1024 * 2;
constexpr size_t OFF_WKV = OFF_WQ + (size_t)768 * 384 * 2;
constexpr size_t OFF_WA = OFF_WKV + (size_t)1024 * 256 * 2;
constexpr size_t OFF_WB = OFF_WA + (size_t)1024 * 1024 * 2;
constexpr size_t OFF_WC = OFF_WB + (size_t)1024 * 1024 * 2;
constexpr size_t OFF_WD = OFF_WC + (size_t)1024 * 1024 * 2;
constexpr size_t OFF_WO = OFF_WD + (size_t)1024 * 1024 * 2;
constexpr size_t OFF_HB = OFF_WO + (size_t)1024 * 1024 * 2;
constexpr size_t OFF_AA = OFF_HB + (size_t)T_ALL * 1024 * 2;
constexpr size_t OFF_AB = OFF_AA + (size_t)T_ALL * 1024 * 2;
constexpr size_t OFF_AC = OFF_AB + 512 * 2;
constexpr size_t OFF_AD = OFF_AB + (size_t)T_ALL * 1024 * 2;
constexpr size_t OFF_GRP = OFF_AD + (size_t)T_ALL * 1024 * 2;
constexpr size_t G_U = 0;
constexpr size_t G_DTRAW = G_U + (size_t)TG * UW * 2;
constexpr size_t G_GLR = G_DTRAW + (size_t)TG * 32 * 4;
constexpr size_t G_DTV = G_GLR + (size_t)TG * 32 * 4;
constexpr size_t G_XC = G_DTV + (size_t)TG * 32 * 4;
constexpr size_t G_QM = G_XC + (size_t)TG * 1536 * 2;
constexpr size_t G_KM = G_QM + (size_t)TG * 768 * 2;
constexpr size_t G_VM = G_KM + (size_t)TG * 768 * 2;
constexpr size_t G_QG = G_VM + (size_t)TG * 512 * 2;
constexpr size_t G_KG = G_QG + (size_t)TG * 512 * 2;
constexpr size_t G_YF = G_KG + (size_t)TG * 128 * 2;
constexpr size_t G_YB = G_YF + (size_t)TG * 1024 * 2;
constexpr size_t G_OF = G_YB + (size_t)TG * 1024 * 2;
constexpr size_t G_OB = G_OF + (size_t)TG * 512 * 2;
constexpr size_t G_END = G_OB + (size_t)TG * 512 * 2;
constexpr size_t P5_MIXED = 0;
constexpr size_t P5_SCR = (size_t)T_ALL * 1024 * 2;
constexpr size_t P5_SCR_PER = (size_t)256 * 256 * 2 + (size_t)256 * 256 * 4;
constexpr int MAX_GRID = 256;
static_assert(P5_SCR + MAX_GRID * P5_SCR_PER <= G_END, "p5 scratch must fit the group area");
constexpr size_t OFF_CTR = OFF_GRP + G_END;
constexpr size_t OFF_BAR = OFF_CTR + 4096;
constexpr size_t OFF_GDEC = OFF_BAR + 16384;
constexpr size_t WS_NEED = OFF_GDEC + (size_t)GSEQ * 32 * 4 * 2 * 64 * 4;
static_assert(WS_NEED <= (size_t)536870912, "workspace budget");

constexpr int STAGE_BYTES = 131072;
constexpr int LDS_BYTES = STAGE_BYTES + 2048 + 64;

struct Params {
    const float* in[24];
    float* out; char* ws;
};

DI unsigned pk(float a, float b) { f32x2 v = {a, b}; bf16x2_t r = __builtin_convertvector(v, bf16x2_t); return __builtin_bit_cast(unsigned, r); }
DI u16 f2bf(float a) { return (u16)(pk(a, 0.f) & 0xffffu); }
DI float bflo(unsigned w) { return __uint_as_float(w << 16); }
DI float bfhi(unsigned w) { return __uint_as_float(w & 0xffff0000u); }
DI float bf2f(u16 b) { return __uint_as_float(((unsigned)b) << 16); }
DI float sigmf(float v) { return __builtin_amdgcn_rcpf(1.f + __builtin_amdgcn_exp2f(-v * 1.4426950408889634f)); }
DI float siluf(float v) { return v * sigmf(v); }
DI float softplusf(float v) { return fmaxf(v, 0.f) + log1pf(__expf(-fabsf(v))); }
DI float fexp2(float v) { return __builtin_amdgcn_exp2f(v); }
DI float fexp(float v) { return __builtin_amdgcn_exp2f(v * LOG2E); }
DI int opaque(int v) { asm volatile("" : "+v"(v)); return v; }
DI int crow(int i, int h) { return (i & 3) + 8 * (i >> 2) + 4 * h; }
#define MFMA32(a, b, c) __builtin_amdgcn_mfma_f32_32x32x16_bf16((a), (b), (c), 0, 0, 0)
DI void unpack8(const u32x4 w, float* f) { f[0] = bflo(w.x); f[1] = bfhi(w.x); f[2] = bflo(w.y); f[3] = bfhi(w.y); f[4] = bflo(w.z); f[5] = bfhi(w.z); f[6] = bflo(w.w); f[7] = bfhi(w.w); }
DI u32x4 pack8(const float* f) { u32x4 w; w.x = pk(f[0], f[1]); w.y = pk(f[2], f[3]); w.z = pk(f[4], f[5]); w.w = pk(f[6], f[7]); return w; }
DI void sincos_rope(float ang, float& c, float& s) { const float rev = ang * 0.15915494309189535f; const float fr = rev - floorf(rev); c = __builtin_amdgcn_cosf(fr); s = __builtin_amdgcn_sinf(fr); }
DI f32x16 zero16() { f32x16 z;
#pragma unroll
    for (int i = 0; i < 16; ++i) z[i] = 0.f; return z; }
DI bf16x8 frag_tr(const char* base, int pitch, int k0, int m0, int lane) {
    const int i16 = lane & 15, q = i16 >> 2, p = i16 & 3, blk = (lane >> 4) & 1, h = lane >> 5;
    const char* a = base + (k0 + 8 * h + q) * pitch + (m0 + 16 * blk + 4 * p) * 2;
    const s16x4 lo = __builtin_amdgcn_ds_read_tr16_b64_v4i16((LAS s16x4*)a);
    const s16x4 hi = __builtin_amdgcn_ds_read_tr16_b64_v4i16((LAS s16x4*)(a + 4 * pitch));
    return __builtin_shufflevector(lo, hi, 0, 1, 2, 3, 4, 5, 6, 7);
}
DI bf16x8 lds_frag(const char* p) { return *(const LAS bf16x8*)p; }


#define XB_TMO      128
#define XB_XCNT(j)  (256  + 64 * (j))
#define XB_XSUB(j)  (1280 + 64 * (j))
#define XB_XGEN(j)  (2304 + 64 * (j))
#define XB_TOP      3328
#define XB_TOPGEN   3392
#define XB_SPIN_CAP (1u << 22)
DI unsigned xb_ld(unsigned* p) { return __hip_atomic_load(p, __ATOMIC_RELAXED, __HIP_MEMORY_SCOPE_AGENT); }
DI unsigned xb_add(unsigned* p, unsigned v) { return __hip_atomic_fetch_add(p, v, __ATOMIC_RELAXED, __HIP_MEMORY_SCOPE_AGENT); }
DI unsigned xb_xcc_id() { return (unsigned)__builtin_amdgcn_s_getreg((3 << 11) | 20) & 0xFu; }
#define XB_SPIN(cond, bar) do { unsigned _sp = 0; while (cond) { __builtin_amdgcn_s_sleep(1); \
    if ((++_sp & 255u) == 0u) { if (xb_ld(&(bar)[XB_TMO])) break; if (_sp > XB_SPIN_CAP) { atomicAdd(&(bar)[XB_TMO], 1u); break; } } } } while (0)
struct XcdBarrier { unsigned* bar; unsigned x; volatile LAS unsigned* st; };
DI XcdBarrier xcd_barrier_post(unsigned* bar, volatile LAS unsigned* st) {
    XcdBarrier b; b.bar = bar; b.x = xb_xcc_id(); b.st = st;
    if (threadIdx.x == 0) (void)xb_add(&bar[XB_XCNT(b.x)], 1u);
    return b;
}
DI void xcd_barrier_complete(unsigned* bar, unsigned x, unsigned& nloc, unsigned& nx) {
    const unsigned G = gridDim.x * gridDim.y * gridDim.z;
    unsigned sum, cnt, mine, sp = 0u;
    for (;;) {
        sum = 0u; cnt = 0u; mine = 0u;
#pragma unroll
        for (unsigned j = 0; j < 16; ++j) { const unsigned c = xb_ld(&bar[XB_XCNT(j)]); sum += c; cnt += (c > 0u) ? 1u : 0u; mine = (j == x) ? c : mine; }
        if (sum == G) break;
        __builtin_amdgcn_s_sleep(1);
        if ((++sp & 255u) == 0u) { if (xb_ld(&bar[XB_TMO])) break; if (sp > XB_SPIN_CAP) { atomicAdd(&bar[XB_TMO], 1u); break; } }
    }
    nloc = mine > 0u ? mine : 1u; nx = cnt > 0u ? cnt : 1u;
}
DI void xcd_barrier(const XcdBarrier& b) {
    asm volatile("s_waitcnt vmcnt(0)" ::: "memory");
    __syncthreads();
    if (threadIdx.x == 0) {
        unsigned* bar = b.bar;
        __builtin_amdgcn_s_waitcnt(0);
        unsigned nloc = b.st[0], nx = b.st[1];
        if (nloc == 0u) { xcd_barrier_complete(bar, b.x, nloc, nx); b.st[0] = nloc; b.st[1] = nx; }
        const unsigned old = xb_add(&bar[XB_XSUB(b.x)], 1u);
        const unsigned gen = old / nloc;
        if (old + 1u == (gen + 1u) * nloc) {
            __builtin_amdgcn_fence(__ATOMIC_RELEASE, "agent");
            asm volatile("s_waitcnt vmcnt(0)" ::: "memory");
            const unsigned og = xb_add(&bar[XB_TOP], 1u);
            const unsigned tg = og / nx;
            if (og + 1u == (tg + 1u) * nx) xb_add(&bar[XB_TOPGEN], 1u);
            else XB_SPIN(xb_ld(&bar[XB_TOPGEN]) == tg, bar);
            __builtin_amdgcn_fence(__ATOMIC_ACQUIRE, "agent");
            xb_add(&bar[XB_XGEN(b.x)], 1u);
            asm volatile("s_waitcnt vmcnt(0)" ::: "memory");
        } else {
            XB_SPIN(xb_ld(&bar[XB_XGEN(b.x)]) == gen, bar);
            __builtin_amdgcn_fence(__ATOMIC_ACQUIRE, "agent");
            asm volatile("s_waitcnt vmcnt(0)" ::: "memory");
        }
    }
    __syncthreads();
}

namespace pg8 {
constexpr int BM = 256, BK = 64, HALF = 128, HTB = HALF * BK * 2, NXCD = 8, WGM = 8;
DI int lds_byte(int r, int c) { const int st = (r >> 4) * 2 + (c >> 5), rr = r & 15, cc = c & 31, ob = rr * 64 + cc * 2; return st * 1024 + (ob ^ (((ob >> 9) & 1) << 5)); }
DI void stage_rc(int b, int& R, int& C) { const int st = b / 1024, sb = b % 1024, swz = sb ^ (((sb >> 9) & 1) << 5); R = (st >> 1) * 16 + swz / 64; C = (st & 1) * 32 + (swz % 64) / 2; }
DI int perm32(int rho) { const int n = rho >> 4, i = rho & 15; return 8 * (i >> 2) + 4 * n + (i & 3); }
struct Unit { int pm, pn; const u16* A; const u16* Bt; int nt, tag; };
DI void tile_map(int L, int nM, int nN, Unit& u) {
    const int nwg = nM * nN; int wgid = L;
    { const int q = nwg / NXCD, r = nwg % NXCD, xcd = wgid % NXCD, off = wgid / NXCD; wgid = (xcd < r ? xcd * (q + 1) : r * (q + 1) + (xcd - r) * q) + off; }
    const int nig = WGM * nN, gid = wgid / nig, fm = gid * WGM, gsz = (nM - fm) < WGM ? (nM - fm) : WGM;
    u.pm = fm + ((wgid % nig) % gsz); u.pn = (wgid % nig) / gsz;
}
struct Gemm { const u16* A; int lda; const u16* Bt; int ldb; int K; };
struct Strided { Gemm g; int nM, nN, first, stride, pn0; int lda, ldb;
    DI bool next(int i, Unit& u) const { const int L = first + i * stride; if (L >= nM * nN) return false; tile_map(L, nM, nN, u); u.pn = (pn0 >= 0) ? u.pn + pn0 : ((u.pn < 2 ? 20 : 22) + u.pn);
        u.A = g.A; u.Bt = g.Bt; u.nt = g.K / BK; u.tag = 0; return true; } };
struct OneUnit { Gemm g; int pm, pn; int lda, ldb;
    DI bool next(int i, Unit& u) const { if (i != 0) return false; u.pm = pm; u.pn = pn; u.A = g.A; u.Bt = g.Bt; u.nt = g.K / BK; u.tag = 0; return true; } };

template <class Epi, class Sched>
DI void gemm_phase(LAS unsigned char* lds, const Sched& S, const Epi& E) {
    const int tid = opaque(threadIdx.x), wid = __builtin_amdgcn_readfirstlane(tid >> 6), lane = tid & 63, wr = wid >> 2, wc = wid & 3, fr = lane & 15, fq = lane >> 4;
    const size_t kstep = (size_t)(BK * 2);
    const unsigned ldsw = (unsigned)wid * 1024u;
    const int aoff = lds_byte(wr * 64 + fr, fq * 8), boff = lds_byte(wc * 32 + fr, fq * 8);
#define PG8_SA(b, h) (((b) * 2 + (h)) * HTB)
#define PG8_SB(b, h) ((4 + (b) * 2 + (h)) * HTB)
#define PG8_STAGE(bufoff, gbase, voff) do { _Pragma("unroll") for (int _i = 0; _i < 2; ++_i) \
        __builtin_amdgcn_global_load_lds((const unsigned*)((const char*)(gbase) + (voff)[_i]), (LAS unsigned*)(lds + (bufoff) + ldsw + _i * 8192), 16, 0, 0); } while (0)
#define PG8_LDA(dst, b, h) do { _Pragma("unroll") for (int m = 0; m < 4; ++m) _Pragma("unroll") for (int k = 0; k < 2; ++k) dst[m][k] = *(const LAS bf16x8*)(lds + PG8_SA(b, h) + aoff + m * 2048 + k * 1024); } while (0)
#define PG8_LDB(dst, b, h) do { _Pragma("unroll") for (int n = 0; n < 2; ++n) _Pragma("unroll") for (int k = 0; k < 2; ++k) dst[n][k] = *(const LAS bf16x8*)(lds + PG8_SB(b, h) + boff + n * 2048 + k * 1024); } while (0)
#define PG8_MMA(ai, bj, At, Bt) do { __builtin_amdgcn_s_setprio(1); _Pragma("unroll") for (int m = 0; m < 4; ++m) _Pragma("unroll") for (int n = 0; n < 2; ++n) _Pragma("unroll") for (int k = 0; k < 2; ++k) \
        acc[ai][bj][m][n] = __builtin_amdgcn_mfma_f32_16x16x32_bf16(Bt[n][k], At[m][k], acc[ai][bj][m][n], 0, 0, 0); __builtin_amdgcn_s_setprio(0); } while (0)
#define PG8_WAIT_V(n) asm volatile("s_waitcnt vmcnt(" #n ")" ::: "memory")
#define PG8_WAIT_L(n) asm volatile("s_waitcnt lgkmcnt(" #n ")" ::: "memory")
#define PG8_BAR __builtin_amdgcn_s_barrier()
#define PG8_SCHED __builtin_amdgcn_sched_barrier(0)
    Unit cur, nxt; int ui = 0;
    if (!S.next(0, cur)) return;
    unsigned voffA[2], voffB[2];
#pragma unroll
    for (int i = 0; i < 2; ++i) { int R, C; stage_rc(tid * 16 + i * 8192, R, C); const int Rb = (R & ~31) + perm32(R & 31);
        voffA[i] = (unsigned)(R * S.lda + C) * 2u; voffB[i] = (unsigned)(Rb * S.ldb + C) * 2u; }
    const size_t hstepA = (size_t)HALF * S.lda * 2, hstepB = (size_t)HALF * S.ldb * 2;
    f32x4 acc[2][2][4][2];
#pragma unroll
    for (int a = 0; a < 2; ++a)
#pragma unroll
        for (int b = 0; b < 2; ++b)
#pragma unroll
            for (int m = 0; m < 4; ++m)
#pragma unroll
                for (int n = 0; n < 2; ++n) acc[a][b][m][n] = (f32x4){0.f, 0.f, 0.f, 0.f};
    bf16x8 At[4][2], B0[2][2], B1[2][2];
    const char* cA = (const char*)cur.A + (size_t)cur.pm * 2 * hstepA; const char* cB = (const char*)cur.Bt + (size_t)cur.pn * 2 * hstepB;
    PG8_STAGE(PG8_SB(0, 0), cB, voffB); PG8_STAGE(PG8_SA(0, 0), cA, voffA); PG8_STAGE(PG8_SB(0, 1), cB + hstepB, voffB); PG8_STAGE(PG8_SA(0, 1), cA + hstepA, voffA);
    if (wr == 1) PG8_BAR;
    PG8_WAIT_V(4); PG8_BAR;
    PG8_STAGE(PG8_SB(1, 0), cB + kstep, voffB); PG8_STAGE(PG8_SA(1, 0), cA + kstep, voffA); PG8_STAGE(PG8_SB(1, 1), cB + hstepB + kstep, voffB);
    PG8_WAIT_V(6); PG8_BAR;
    for (;;) {
        const bool has_next = S.next(ui + 1, nxt);
        if (!has_next) nxt = cur;
        const char* nA = (const char*)nxt.A + (size_t)nxt.pm * 2 * hstepA; const char* nB = (const char*)nxt.Bt + (size_t)nxt.pn * 2 * hstepB;
        const int nt = cur.nt;
#pragma unroll 1
        for (int t = 0; t < nt; t += 2) {
            const bool last = (t == nt - 2);
            const char* a1 = cA + (size_t)(t + 1) * kstep;
            const char* a2 = last ? nA : cA + (size_t)(t + 2) * kstep; const char* b2 = last ? nB : cB + (size_t)(t + 2) * kstep;
            const char* a3 = a2 + kstep; const char* b3 = b2 + kstep;
            PG8_LDB(B0, 0, 0); PG8_SCHED; PG8_LDA(At, 0, 0); PG8_STAGE(PG8_SA(1, 1), a1 + hstepA, voffA);
            PG8_WAIT_L(8); PG8_BAR; PG8_WAIT_L(0); PG8_MMA(0, 0, At, B0); PG8_BAR; PG8_SCHED;
            PG8_LDB(B1, 0, 1); PG8_STAGE(PG8_SB(0, 0), b2, voffB);
            PG8_BAR; PG8_WAIT_L(0); PG8_MMA(0, 1, At, B1); PG8_BAR;
            PG8_LDA(At, 0, 1); PG8_STAGE(PG8_SA(0, 0), a2, voffA);
            PG8_BAR; PG8_WAIT_L(0); PG8_MMA(1, 0, At, B0); PG8_BAR; PG8_SCHED;
            PG8_STAGE(PG8_SB(0, 1), b2 + hstepB, voffB);
            PG8_WAIT_V(6); PG8_BAR; PG8_MMA(1, 1, At, B1); PG8_BAR;
            PG8_LDB(B0, 1, 0); PG8_SCHED; PG8_LDA(At, 1, 0); PG8_STAGE(PG8_SA(0, 1), a2 + hstepA, voffA);
            PG8_WAIT_L(8); PG8_BAR; PG8_WAIT_L(0); PG8_MMA(0, 0, At, B0); PG8_BAR; PG8_SCHED;
            PG8_LDB(B1, 1, 1); PG8_STAGE(PG8_SB(1, 0), b3, voffB);
            PG8_BAR; PG8_WAIT_L(0); PG8_MMA(0, 1, At, B1); PG8_BAR;
            PG8_LDA(At, 1, 1); PG8_STAGE(PG8_SA(1, 0), a3, voffA);
            PG8_BAR; PG8_WAIT_L(0); PG8_MMA(1, 0, At, B0); PG8_BAR; PG8_SCHED;
            PG8_STAGE(PG8_SB(1, 1), b3 + hstepB, voffB);
            PG8_WAIT_V(6); PG8_BAR; PG8_MMA(1, 1, At, B1); PG8_BAR;
        }
        E(acc, cur, wr, wc, fr, fq);
        if (!has_next) break;
#pragma unroll
        for (int a = 0; a < 2; ++a)
#pragma unroll
            for (int b = 0; b < 2; ++b)
#pragma unroll
                for (int m = 0; m < 4; ++m)
#pragma unroll
                    for (int n = 0; n < 2; ++n) acc[a][b][m][n] = (f32x4){0.f, 0.f, 0.f, 0.f};
        cur = nxt; cA = nA; cB = nB; ++ui;
    }
    PG8_WAIT_V(0);
    if (wr == 0) PG8_BAR;
    PG8_BAR;
#undef PG8_SA
#undef PG8_SB
#undef PG8_STAGE
#undef PG8_LDA
#undef PG8_LDB
#undef PG8_MMA
#undef PG8_WAIT_V
#undef PG8_WAIT_L
#undef PG8_BAR
#undef PG8_SCHED
}

template <class F> DI void epi_rows(const f32x4 (&acc)[2][2][4][2], const Unit& u, int wr, int wc, int fr, int fq, const F& f) {
    const int row0 = u.pm * BM + wr * 64 + fr, col0 = u.pn * BM + wc * 32 + 8 * fq;
#pragma unroll
    for (int ai = 0; ai < 2; ++ai)
#pragma unroll
        for (int m = 0; m < 4; ++m)
#pragma unroll
            for (int bj = 0; bj < 2; ++bj) f(row0 + ai * HALF + m * 16, col0 + bj * HALF, acc[ai][bj][m][0], acc[ai][bj][m][1]);
}
DI u32x4 pack_v(const f32x4 a, const f32x4 b) { u32x4 w; w.x = pk(a[0], a[1]); w.y = pk(a[2], a[3]); w.z = pk(b[0], b[1]); w.w = pk(b[2], b[3]); return w; }

struct EpiInproj { u16* u; float* dtraw; float* glr;
    DI void operator()(const f32x4 (&acc)[2][2][4][2], const Unit& un, int wr, int wc, int fr_, int fq_) const {
        const int fr = opaque(fr_), fq = opaque(fq_);
        epi_rows(acc, un, wr, wc, fr, fq, [&](int row, int col, f32x4 a, f32x4 b) {
            if (col >= U_ZA) {
#pragma unroll
                for (int j = 0; j < 4; ++j) { a[j] = siluf(a[j]); b[j] = siluf(b[j]); } }
            if (col >= U_DT && col < U_DT + 32) { float* d = dtraw + (size_t)row * 32 + (col - U_DT); *(f32x4*)d = a; *(f32x4*)(d + 4) = b; }
            if (col >= U_GLR && col < U_GLR + 32) { float* d = glr + (size_t)row * 32 + (col - U_GLR); *(f32x4*)d = a; *(f32x4*)(d + 4) = b; }
            *(u32x4*)(u + (size_t)row * UW + col) = pack_v(a, b);
        });
    } };
struct EpiQ { u16* q; const LAS float* rs;
    DI void operator()(const f32x4 (&acc)[2][2][4][2], const Unit& un, int wr, int wc, int fr, int fq) const {
        epi_rows(acc, un, wr, wc, fr, fq, [&](int row, int col, f32x4 a, f32x4 b) {
            const float s = rs[row - un.pm * BM];
            *(u32x4*)(q + (size_t)row * 768 + col) = pack_v(a * s, b * s);
        });
    } };
struct EpiKV { u16* km; u16* vm; const LAS float* rs;
    DI void operator()(const f32x4 (&acc)[2][2][4][2], const Unit& un, int wr, int wc, int fr, int fq) const {
        epi_rows(acc, un, wr, wc, fr, fq, [&](int row, int col, f32x4 a, f32x4 b) {
            const float s = rs[row - un.pm * BM];
            const int head = col >> 7, c = col & 127;
            u16* d = (c < 64) ? (km + (size_t)row * 768 + head * 96 + c) : (vm + (size_t)row * 512 + head * 64 + (c - 64));
            *(u32x4*)d = pack_v(a * s, b * s);
        });
    } };
struct EpiGate { u16* sg;
    DI void operator()(const f32x4 (&acc)[2][2][4][2], const Unit& un, int wr, int wc, int fr, int fq) const {
        epi_rows(acc, un, wr, wc, fr, fq, [&](int row, int col, f32x4 a, f32x4 b) {
#pragma unroll
            for (int j = 0; j < 4; ++j) { a[j] = sigmf(a[j]); b[j] = sigmf(b[j]); }
            *(u32x4*)(sg + (row - un.pm * BM) * 256 + (col - un.pn * BM)) = pack_v(a, b);
        });
    } };
struct EpiBranch { const u16* sg; float* sacc; u16* mixed; int first, last;
    DI void operator()(const f32x4 (&acc)[2][2][4][2], const Unit& un, int wr, int wc, int fr, int fq) const {
        const int lr0 = wr * 64 + fr, lc0 = wc * 32 + 8 * fq;
#pragma unroll
        for (int ai = 0; ai < 2; ++ai) {
            u32x4 gw[4][2], mw[4][2];
#pragma unroll
            for (int m = 0; m < 4; ++m)
#pragma unroll
                for (int bj = 0; bj < 2; ++bj) { const int lr = lr0 + ai * HALF + m * 16, lc = lc0 + bj * HALF;
                    gw[m][bj] = *(const u32x4*)(sg + lr * 256 + lc);
                    mw[m][bj] = first ? (u32x4){0u, 0u, 0u, 0u} : *(const u32x4*)(mixed + (size_t)(un.pm * BM + lr) * 1024 + un.pn * BM + lc); }
#pragma unroll
            for (int m = 0; m < 4; ++m)
#pragma unroll
                for (int bj = 0; bj < 2; ++bj) { const int lr = lr0 + ai * HALF + m * 16, lc = lc0 + bj * HALF;
                    const u32x4 g = gw[m][bj], w = mw[m][bj];
                    f32x4 a = acc[ai][bj][m][0] * (f32x4){bflo(g.x), bfhi(g.x), bflo(g.y), bfhi(g.y)} + (f32x4){bflo(w.x), bfhi(w.x), bflo(w.y), bfhi(w.y)};
                    f32x4 bb = acc[ai][bj][m][1] * (f32x4){bflo(g.z), bfhi(g.z), bflo(g.w), bfhi(g.w)} + (f32x4){bflo(w.z), bfhi(w.z), bflo(w.w), bfhi(w.w)};
                    *(u32x4*)(mixed + (size_t)(un.pm * BM + lr) * 1024 + un.pn * BM + lc) = pack_v(a, bb); }
        }
    } };
struct EpiP5 { u16* sg; float* sacc; u16* mixed;
    DI void operator()(const f32x4 (&acc)[2][2][4][2], const Unit& un, int wr, int wc, int fr_, int fq_) const {
        const int fr = opaque(fr_), fq = opaque(fq_);
        if (un.tag & 1) { EpiBranch e{sg, sacc, mixed, (un.tag >> 1) == 0, (un.tag >> 1) == 3}; e(acc, un, wr, wc, fr, fq); }
        else { EpiGate e{sg}; e(acc, un, wr, wc, fr, fq); }
    } };
struct P5Sched { const char* ws; int first, stride; int lda, ldb;
    DI bool next(int i, Unit& u) const { const int tile = i >> 3, pass = i & 7, br = pass >> 1; const int L = first + tile * stride; if (L >= 512) return false; tile_map(L, 128, 4, u);
        if (pass & 1) { u.A = (const u16*)(ws + (br == 0 ? OFF_AA : br == 1 ? OFF_AB : br == 2 ? OFF_AC : OFF_AD)); u.Bt = (const u16*)(ws + (br == 0 ? OFF_WA : br == 1 ? OFF_WB : br == 2 ? OFF_WC : OFF_WD));
            u.nt = (br == 0 ? 1024 : 512) / BK; }
        else { u.A = (const u16*)(ws + OFF_HB); u.Bt = (const u16*)(ws + OFF_WALL) + (size_t)br * 1024 * 1024; u.nt = 16; }
        u.tag = pass; return true; } };
struct EpiOut { const float* xin; float* out;
    DI void operator()(const f32x4 (&acc)[2][2][4][2], const Unit& un, int wr, int wc, int fr_, int fq_) const {
        const int fr = opaque(fr_), fq = opaque(fq_);
        const int row0 = un.pm * BM + wr * 64 + fr, col0 = un.pn * BM + wc * 32 + 8 * fq;
#pragma unroll
        for (int ai = 0; ai < 2; ++ai) {
            f32x4 x0[4][2], x1[4][2];
#pragma unroll
            for (int m = 0; m < 4; ++m)
#pragma unroll
                for (int bj = 0; bj < 2; ++bj) { const size_t o = (size_t)(row0 + ai * HALF + m * 16) * 1024 + col0 + bj * HALF; x0[m][bj] = *(const f32x4*)(xin + o); x1[m][bj] = *(const f32x4*)(xin + o + 4); }
#pragma unroll
            for (int m = 0; m < 4; ++m)
#pragma unroll
                for (int bj = 0; bj < 2; ++bj) { const size_t o = (size_t)(row0 + ai * HALF + m * 16) * 1024 + col0 + bj * HALF;
                    *(f32x4*)(out + o) = x0[m][bj] + acc[ai][bj][m][0]; *(f32x4*)(out + o + 4) = x1[m][bj] + acc[ai][bj][m][1]; }
        }
    } };
}

template <bool REMAP> DI void wtile(char* shm, const float* src, int ld, int K, int N, u16* dst, int dpitch, const float* scale, int tile) {
    const int tid = opaque(threadIdx.x), lane = tid & 63, wave = __builtin_amdgcn_readfirstlane(tid >> 6);
    float* tl = (float*)(shm + wave * 16640);
    const int nkt = K / 64, kt = tile % nkt, ntile = tile / nkt, k0 = kt * 64, n0 = ntile * 64;
    { const int n = n0 + lane; const bool ok = n < N; const float* sp = src + (size_t)k0 * ld + (ok ? n : 0);
      float v[64];
#pragma unroll
      for (int k = 0; k < 64; ++k) v[k] = sp[(size_t)k * ld];
#pragma unroll
      for (int k = 0; k < 64; ++k) { float x = ok ? v[k] : 0.f; if (scale) x *= scale[k0 + k]; tl[k * 65 + lane] = x; } }
    __builtin_amdgcn_wave_barrier();
    { const int kp = lane & 31, ns = lane >> 5;
#pragma unroll 8
      for (int i = 0; i < 32; ++i) { const int nl = 2 * i + ns, n = n0 + nl; if (n < N) { const int drow = REMAP ? (n < 4096 ? n : 4096 + ucol_of(n - 4096)) : n;
          *(unsigned*)(dst + (size_t)drow * dpitch + k0 + 2 * kp) = pk(tl[(2 * kp) * 65 + nl], tl[(2 * kp + 1) * 65 + nl]); } } }
    __builtin_amdgcn_wave_barrier();
}
DI void phase_weights(char* shm, const Params& p, int layer) {
    char* ws = p.ws;
    if (blockIdx.x == 0) { u32x4* z = (u32x4*)((u16*)(ws + OFF_WALL) + (size_t)(4096 + U_PAD) * 1024); for (int i = opaque(threadIdx.x); i < 32 * 1024 * 2 / 16; i += 512) z[i] = (u32x4){0u, 0u, 0u, 0u}; }
    const int c0 = 16 * 168, c1 = c0 + 6 * 12, c2 = c1 + 4 * 16, c3 = c2 + 256, c4 = c3 + 128, c5 = c4 + 128, c6 = c5 + 128, c7 = c6 + 256;
    const int gw_ = blockIdx.x * 8 + __builtin_amdgcn_readfirstlane(opaque(threadIdx.x) >> 6);
    for (int t = gw_; t < c7; t += gridDim.x * 8) {
        if (t < c0) wtile<true>(shm, p.in[2] + (size_t)layer * 1024 * NIN, NIN, 1024, NIN, (u16*)(ws + OFF_WALL), 1024, nullptr, t);
        else if (t < c1) wtile<false>(shm, p.in[11] + (size_t)layer * 384 * 768, 768, 384, 768, (u16*)(ws + OFF_WQ), 384, p.in[9] + layer * 384, t - c0);
        else if (t < c2) wtile<false>(shm, p.in[12] + (size_t)layer * 256 * 1024, 1024, 256, 1024, (u16*)(ws + OFF_WKV), 256, p.in[10] + layer * 256, t - c1);
        else if (t < c3) wtile<false>(shm, p.in[18] + (size_t)layer * 1024 * 1024, 1024, 1024, 1024, (u16*)(ws + OFF_WA), 1024, nullptr, t - c2);
        else if (t < c4) wtile<false>(shm, p.in[19] + (size_t)layer * 512 * 1024, 1024, 512, 1024, (u16*)(ws + OFF_WB), 1024, nullptr, t - c3);
        else if (t < c5) wtile<false>(shm, p.in[20] + (size_t)layer * 512 * 1024, 1024, 512, 1024, (u16*)(ws + OFF_WC), 1024, nullptr, t - c4);
        else if (t < c6) wtile<false>(shm, p.in[21] + (size_t)layer * 512 * 1024, 1024, 512, 1024, (u16*)(ws + OFF_WD), 1024, nullptr, t - c5);
        else wtile<false>(shm, p.in[22] + (size_t)layer * 1024 * 1024, 1024, 1024, 1024, (u16*)(ws + OFF_WO), 1024, nullptr, t - c6);
    }
}

DI float wave_sum(float v) {
#pragma unroll
    for (int o = 32; o >= 1; o >>= 1) v += __shfl_xor(v, o);
    return v;
}
template <bool FINAL> DI void phase_rownorm(const float* xin, const float* g, u16* hb, float* fout) {
    const int tidx = opaque(threadIdx.x); const int lane = tidx & 63, gw = blockIdx.x * 8 + (tidx >> 6), nw = gridDim.x * 8;
    f32x4 gg[4];
#pragma unroll
    for (int i = 0; i < 4; ++i) gg[i] = ((const f32x4*)g)[lane + 64 * i];
    for (int row = gw; row < T_ALL; row += 2 * nw) {
        const int row1 = row + nw; const bool has1 = row1 < T_ALL;
        const f32x4* xr0 = (const f32x4*)(xin + (size_t)row * 1024); const f32x4* xr1 = (const f32x4*)(xin + (size_t)(has1 ? row1 : row) * 1024);
        f32x4 v0[4], v1[4]; float s0 = 0.f, s1 = 0.f;
#pragma unroll
        for (int i = 0; i < 4; ++i) { v0[i] = xr0[lane + 64 * i]; v1[i] = xr1[lane + 64 * i]; }
#pragma unroll
        for (int i = 0; i < 4; ++i) { s0 += v0[i][0] * v0[i][0] + v0[i][1] * v0[i][1] + v0[i][2] * v0[i][2] + v0[i][3] * v0[i][3]; s1 += v1[i][0] * v1[i][0] + v1[i][1] * v1[i][1] + v1[i][2] * v1[i][2] + v1[i][3] * v1[i][3]; }
        s0 = wave_sum(s0); s1 = wave_sum(s1);
        const float r0 = rsqrtf(s0 * (1.f / 1024.f) + EPS), r1 = rsqrtf(s1 * (1.f / 1024.f) + EPS);
#pragma unroll
        for (int i = 0; i < 4; ++i) { const f32x4 o0 = v0[i] * r0 * gg[i], o1 = v1[i] * r1 * gg[i];
            if (FINAL) { ((f32x4*)(fout + (size_t)row * 1024))[lane + 64 * i] = o0; if (has1) ((f32x4*)(fout + (size_t)row1 * 1024))[lane + 64 * i] = o1; }
            else { u32x2 w; w.x = pk(o0[0], o0[1]); w.y = pk(o0[2], o0[3]); *(u32x2*)(hb + (size_t)row * 1024 + 4 * (lane + 64 * i)) = w;
                   if (has1) { w.x = pk(o1[0], o1[1]); w.y = pk(o1[2], o1[3]); *(u32x2*)(hb + (size_t)row1 * 1024 + 4 * (lane + 64 * i)) = w; } } }
    }
}

template <int K> DI void rowstat(char* shm, const u16* A, int lda, int row0) {
    const int tid = opaque(threadIdx.x), r = tid >> 1, half = tid & 1; constexpr int N16 = K / 16;
    const u32x4* src = (const u32x4*)(A + (size_t)(row0 + r) * lda + half * (K / 2));
    u32x4 v[N16];
#pragma unroll
    for (int i = 0; i < N16; ++i) v[i] = src[i];
    float ss = 0.f;
#pragma unroll
    for (int i = 0; i < N16; ++i) { float f[8]; unpack8(v[i], f);
#pragma unroll
        for (int j = 0; j < 8; ++j) ss += f[j] * f[j]; }
    ss += __shfl_xor(ss, 1);
    if (half == 0) ((float*)(shm + STAGE_BYTES))[r] = rsqrtf(ss / (float)K + EPS);
    __syncthreads();
}
DI void conv_task(const Params& p, int layer, char* grp, int task, int lane_in) {
    const int lane = opaque(lane_in);
    const int run = task / 3, chunk = task - run * 3, c = chunk * 512 + lane * 8, t0 = run * 16, pos0 = t0 & (SEQ - 1);
    const u16* u = (const u16*)(grp + G_U); u16* xc = (u16*)(grp + G_XC);
    const float* cw = p.in[3] + (size_t)layer * 5 * 1536 + c; const float* cb = p.in[4] + (size_t)layer * 1536 + c;
    u32x4 rows[20];
#pragma unroll
    for (int i = 0; i < 20; ++i) { const int pp = pos0 - 2 + i; rows[i] = (u32x4){0u, 0u, 0u, 0u};
        if (pp >= 0 && pp < SEQ) rows[i] = __builtin_nontemporal_load((const u32x4*)(u + (size_t)(t0 - 2 + i) * UW + U_XBC + c)); }
    float w[5][8], bias[8];
#pragma unroll
    for (int j = 0; j < 5; ++j) { const f32x4 w0 = *(const f32x4*)(cw + j * 1536), w1 = *(const f32x4*)(cw + j * 1536 + 4);
        w[j][0] = w0[0]; w[j][1] = w0[1]; w[j][2] = w0[2]; w[j][3] = w0[3]; w[j][4] = w1[0]; w[j][5] = w1[1]; w[j][6] = w1[2]; w[j][7] = w1[3]; }
    { const f32x4 b0 = *(const f32x4*)cb, b1 = *(const f32x4*)(cb + 4); bias[0] = b0[0]; bias[1] = b0[1]; bias[2] = b0[2]; bias[3] = b0[3]; bias[4] = b1[0]; bias[5] = b1[1]; bias[6] = b1[2]; bias[7] = b1[3]; }
#pragma unroll
    for (int o = 0; o < 16; ++o) { float acc[8];
#pragma unroll
        for (int e = 0; e < 8; ++e) acc[e] = bias[e];
#pragma unroll
        for (int j = 0; j < 5; ++j) { float f[8]; unpack8(rows[o + j], f);
#pragma unroll
            for (int e = 0; e < 8; ++e) acc[e] += f[e] * w[j][e]; }
#pragma unroll
        for (int e = 0; e < 8; ++e) acc[e] = siluf(acc[e]);
        *(u32x4*)(xc + (size_t)(t0 + o) * 1536 + c) = pack8(acc); }
}
template <int NT> DI void prep_tokens(const Params& p, int layer, char* grp, int tg0, int tstride, int lane_in) {
    const int lane = opaque(lane_in);
    const u16* u = (const u16*)(grp + G_U);
    const int cq = lane, ck = lane & 15, cr = lane & 31;
    u32x4 qraw[NT], kraw[NT]; float xr[NT], dr[NT];
#pragma unroll
    for (int k = 0; k < NT; ++k) { const size_t tg = (size_t)(tg0 + k * tstride);
        qraw[k] = *(const u32x4*)(u + tg * UW + U_QD + cq * 8); kraw[k] = *(const u32x4*)(u + tg * UW + U_KD + ck * 8);
        xr[k] = bf2f(u[tg * UW + U_KROPE + cr]); dr[k] = ((const float*)(grp + G_DTRAW))[tg * 32 + cr]; }
    const float dtb = p.in[6][layer * 32 + cr];
#pragma unroll
    for (int k = 0; k < NT; ++k) { const int tg = tg0 + k * tstride; const int pos = tg & (SEQ - 1);
        const float prow = (float)(pos >> 6), pcol = (float)(pos & 63);
        if (lane < 32) ((float*)(grp + G_DTV))[(size_t)tg * 32 + lane] = softplusf(dr[k] + dtb);
#pragma unroll
        for (int which = 0; which < 2; ++which) {
            const int j = lane & 7;
            const float* gn = (which ? p.in[17] : p.in[16]) + layer * 64;
            float f[8]; unpack8(which ? kraw[k] : qraw[k], f);
            float ss = 0.f;
#pragma unroll
            for (int e = 0; e < 8; ++e) ss += f[e] * f[e];
            ss += __shfl_xor(ss, 1); ss += __shfl_xor(ss, 2); ss += __shfl_xor(ss, 4);
            const float rstd = rsqrtf(ss * (1.f / 64.f) + EPS);
            float o[8];
#pragma unroll
            for (int e = 0; e < 8; ++e) f[e] = f[e] * rstd * gn[8 * j + e];
#pragma unroll
            for (int e = 0; e < 8; ++e) { const float pr = __shfl_xor(f[e], 2); const int col = 8 * j + e, i = col & 31, fi = i & 15;
                const float inv = fexp2(-(float)fi * (13.287712379549449f / 16.f)); float c, s_; sincos_rope(((col >> 5) ? pcol : prow) * inv, c, s_);
                o[e] = f[e] * c + ((i < 16) ? -pr : pr) * s_; }
            if (which == 0) *(u32x4*)((u16*)(grp + G_QG) + (size_t)tg * 512 + lane * 8) = pack8(o);
            else if (lane < 16) *(u32x4*)((u16*)(grp + G_KG) + (size_t)tg * 128 + lane * 8) = pack8(o);
        }
        { const int i = cr; const float x = xr[k]; const float pr = __shfl_xor(x, 8); const int ii = i & 15, fi = ii & 7;
          const float inv = fexp2(-(float)fi * (13.287712379549449f / 8.f)); float c, s_; sincos_rope(((i >> 4) ? pcol : prow) * inv, c, s_);
          const u16 o = f2bf(x * c + ((ii < 8) ? -pr : pr) * s_);
          if (lane < 32) { u16* km = (u16*)(grp + G_KM) + (size_t)tg * 768 + 64 + i;
#pragma unroll
              for (int hh = 0; hh < 8; ++hh) km[hh * 96] = o; } }
    }
}

template <int D, bool MLA>
DI void attn_item(char* shm, const u16* Q, int qpitch, const u16* Kp, int kpitch, const u16* V, int vpitch, const u16* Z, int zpitch, u16* O, int opitch, int tok0, int q0, float scale) {
    constexpr int KCH = D / 8, KP = D * 2 + 16, VP = 144, KBYTES = 64 * KP, VBYTES = 64 * VP, BUF = KBYTES + VBYTES, NKK = D / 16;
    const int tid = opaque(threadIdx.x), lane = tid & 63, wave = __builtin_amdgcn_readfirstlane(tid >> 6), r = lane & 31, h = lane >> 5;
    const int qpos = q0 + wave * 32 + r; const size_t qrow = (size_t)(tok0 + qpos);
    bf16x8 qf[NKK];
    { const float sc = scale * LOG2E;
#pragma unroll
      for (int kk = 0; kk < NKK; ++kk) { float f[8]; unpack8(*(const u32x4*)(Q + qrow * qpitch + 16 * kk + 8 * h), f);
          if (MLA && kk >= 4) { const float pv = (kk == 4) ? (float)(qpos >> 6) : (float)(qpos & 63);
#pragma unroll
              for (int j = 0; j < 8; ++j) { const float pr = __shfl_xor(f[j], 32); const float inv = fexp2(-(float)j * (13.287712379549449f / 8.f)); float c, s; sincos_rope(pv * inv, c, s);
                  f[j] = f[j] * c + (h ? pr : -pr) * s; } }
#pragma unroll
          for (int j = 0; j < 8; ++j) f[j] *= sc;
          qf[kk] = __builtin_bit_cast(bf16x8, pack8(f)); } }
    constexpr int TK = 128, KB2 = TK * KP, VB2 = TK * VP, BUF2 = KB2 + VB2, NKC = (KCH * TK + 511) / 512, NT = SEQ / TK;
    struct AttRegs { u32x4 k[NKC]; u32x4 v[2]; };
    AttRegs RA, RB;
#define ATT_GLOAD(kt, R) do { _Pragma("unroll") for (int c_ = 0; c_ < NKC; ++c_) { const int id_ = tid + 512 * c_; if (id_ < KCH * TK) R.k[c_] = *(const u32x4*)(Kp + (size_t)(tok0 + TK * (kt) + id_ / KCH) * kpitch + (id_ % KCH) * 8); } \
        _Pragma("unroll") for (int c_ = 0; c_ < 2; ++c_) { const int id_ = tid + 512 * c_; R.v[c_] = *(const u32x4*)(V + (size_t)(tok0 + TK * (kt) + (id_ >> 3)) * vpitch + (id_ & 7) * 8); } } while (0)
#define ATT_LSTORE(buf, R) do { char* b_ = shm + (buf) * BUF2; \
        _Pragma("unroll") for (int c_ = 0; c_ < NKC; ++c_) { const int id_ = tid + 512 * c_; if (id_ < KCH * TK) *(LAS u32x4*)(b_ + (id_ / KCH) * KP + (id_ % KCH) * 16) = R.k[c_]; } \
        _Pragma("unroll") for (int c_ = 0; c_ < 2; ++c_) { const int id_ = tid + 512 * c_; *(LAS u32x4*)(b_ + KB2 + (id_ >> 3) * VP + (id_ & 7) * 16) = R.v[c_]; } } while (0)
    f32x16 o0 = zero16(), o1 = zero16(); float mrun = 0.f, lsum = 0.f;
    const int i16 = lane & 15, tq = i16 >> 2, tp = i16 & 3, blk = (lane >> 4) & 1;
    __syncthreads();
    ATT_GLOAD(0, RA); ATT_LSTORE(0, RA); ATT_GLOAD(1, RB);
    __syncthreads();
#define ATT_BODY(kt, RL, RS) do { \
        if ((kt) + 2 < NT) ATT_GLOAD((kt) + 2, RL); \
        const char* kb_ = shm + ((kt) & 1) * BUF2; const char* vb_ = kb_ + KB2; \
        f32x16 sc[4]; \
        { const float nm = -mrun; \
          _Pragma("unroll") for (int q = 0; q < 4; ++q) _Pragma("unroll") for (int i = 0; i < 16; ++i) sc[q][i] = nm; } \
        _Pragma("unroll") for (int kk = 0; kk < NKK; ++kk) _Pragma("unroll") for (int q = 0; q < 4; ++q) sc[q] = MFMA32(lds_frag(kb_ + (32 * q + r) * KP + (16 * kk + 8 * h) * 2), qf[kk], sc[q]); \
        _Pragma("unroll") for (int hf = 0; hf < 2; ++hf) {     \
            float mx = sc[2 * hf][0]; \
            _Pragma("unroll") for (int q = 0; q < 2; ++q) _Pragma("unroll") for (int i = 0; i < 16; ++i) mx = fmaxf(mx, sc[2 * hf + q][i]); \
            mx = fmaxf(mx, __shfl_xor(mx, 32)); \
            const bool need = ((kt) == 0 && hf == 0) || (mx > 8.f); \
            if (__builtin_amdgcn_ballot_w64(need) != 0ull) { \
                const float delta = need ? mx : 0.f, alpha = fexp2(fmaxf(-delta, -126.f)); \
                mrun += delta; lsum *= alpha; \
                _Pragma("unroll") for (int i = 0; i < 16; ++i) { o0[i] *= alpha; o1[i] *= alpha; } \
                _Pragma("unroll") for (int q = 2 * hf; q < 4; ++q) _Pragma("unroll") for (int i = 0; i < 16; ++i) sc[q][i] -= delta; \
            } \
            float ps = 0.f; \
            _Pragma("unroll") for (int q = 0; q < 2; ++q) _Pragma("unroll") for (int i = 0; i < 16; ++i) { sc[2 * hf + q][i] = fexp2(sc[2 * hf + q][i]); ps += sc[2 * hf + q][i]; } \
            lsum += ps; \
            _Pragma("unroll") for (int kq = 0; kq < 2; ++kq) _Pragma("unroll") for (int sp = 0; sp < 2; ++sp) { const int kb = 2 * hf + kq; \
                u32x4 pw; \
                pw.x = pk(sc[kb][8 * sp], sc[kb][8 * sp + 1]); pw.y = pk(sc[kb][8 * sp + 2], sc[kb][8 * sp + 3]); pw.z = pk(sc[kb][8 * sp + 4], sc[kb][8 * sp + 5]); pw.w = pk(sc[kb][8 * sp + 6], sc[kb][8 * sp + 7]); \
                const bf16x8 pf = __builtin_bit_cast(bf16x8, pw); \
                const char* va = vb_ + (32 * kb + 16 * sp + 4 * h + tq) * VP + (16 * blk + 4 * tp) * 2; \
                { const s16x4 lo = __builtin_amdgcn_ds_read_tr16_b64_v4i16((LAS s16x4*)va), hi = __builtin_amdgcn_ds_read_tr16_b64_v4i16((LAS s16x4*)(va + 8 * VP)); \
                  o0 = MFMA32(__builtin_shufflevector(lo, hi, 0, 1, 2, 3, 4, 5, 6, 7), pf, o0); } \
                { const s16x4 lo = __builtin_amdgcn_ds_read_tr16_b64_v4i16((LAS s16x4*)(va + 64)), hi = __builtin_amdgcn_ds_read_tr16_b64_v4i16((LAS s16x4*)(va + 64 + 8 * VP)); \
                  o1 = MFMA32(__builtin_shufflevector(lo, hi, 0, 1, 2, 3, 4, 5, 6, 7), pf, o1); } \
            } \
        } \
        if ((kt) + 1 < NT) ATT_LSTORE(((kt) + 1) & 1, RS); \
        __syncthreads(); } while (0)
#pragma unroll 1
    for (int kt = 0; kt < NT; kt += 2) { ATT_BODY(kt, RA, RB); ATT_BODY(kt + 1, RB, RA); }
#undef ATT_BODY
#undef ATT_GLOAD
#undef ATT_LSTORE
    lsum += __shfl_xor(lsum, 32);
    const float inv = 1.f / lsum;
#pragma unroll
    for (int dvt = 0; dvt < 2; ++dvt)
#pragma unroll
        for (int g4 = 0; g4 < 4; ++g4) { const int dv = 32 * dvt + 8 * g4 + 4 * h;
            const u32x2 zw = *(const u32x2*)(Z + qrow * zpitch + dv);
            float v0, v1, v2, v3;
            if (dvt == 0) { v0 = o0[4 * g4]; v1 = o0[4 * g4 + 1]; v2 = o0[4 * g4 + 2]; v3 = o0[4 * g4 + 3]; } else { v0 = o1[4 * g4]; v1 = o1[4 * g4 + 1]; v2 = o1[4 * g4 + 2]; v3 = o1[4 * g4 + 3]; }
            u32x2 w; w.x = pk(v0 * inv * bflo(zw.x), v1 * inv * bfhi(zw.x)); w.y = pk(v2 * inv * bflo(zw.y), v3 * inv * bfhi(zw.y));
            *(u32x2*)(O + qrow * opitch + dv) = w; }
}

DI void ssd_item(char* shm, const Params& p, int layer, char* grp, int item) {
    const int b = item >> 5, hd = (item >> 1) & 15, dir = item & 1, grpi = hd >> 3, tokbase = b * SEQ;
    const int tid = opaque(threadIdx.x), lane = tid & 63, wave = __builtin_amdgcn_readfirstlane(tid >> 6), r = lane & 31, h = lane >> 5;
    char* cm_ = shm; char* bm_ = shm + 17408; char* xd_ = shm + 34816; char* xdd_ = shm + 44032; char* mm_ = shm + 53248; char* sb_ = shm + 62464;
    float* acum = (float*)(shm + 79872); float* dts = acum + 128; float* eacs = acum + 256;
    const u16* xc = (const u16*)(grp + G_XC); const float* dtv = (const float*)(grp + G_DTV);
    u16* yout = (u16*)(grp + (dir ? G_YB : G_YF));
    const float a_neg = -__expf(p.in[5][layer * 32 + dir * 16 + hd]);
    const int lrow0 = tid >> 4, lch = tid & 15, xrow = tid >> 3, xch = tid & 7;
    struct SsdRegs { u32x4 cm0, cm1, bm0, bm1, xs; float dt; };
    SsdRegs RA, RB; RA.dt = 0.f; RB.dt = 0.f;
#define SSD_TOK(tau) ((size_t)(tokbase + (dir ? SEQ - 1 - (tau) : (tau))))
#define SSD_LOADG(c, R) do { const size_t t0_ = SSD_TOK(64 * (c) + lrow0), t1_ = SSD_TOK(64 * (c) + lrow0 + 32); \
        R.cm0 = *(const u32x4*)(xc + t0_ * 1536 + 1280 + 128 * grpi + lch * 8); R.cm1 = *(const u32x4*)(xc + t1_ * 1536 + 1280 + 128 * grpi + lch * 8); \
        R.bm0 = *(const u32x4*)(xc + t0_ * 1536 + 1024 + 128 * grpi + lch * 8); R.bm1 = *(const u32x4*)(xc + t1_ * 1536 + 1024 + 128 * grpi + lch * 8); \
        R.xs = *(const u32x4*)(xc + SSD_TOK(64 * (c) + xrow) * 1536 + hd * 64 + xch * 8); \
        if (tid < 64) R.dt = dtv[SSD_TOK(64 * (c) + tid) * 32 + dir * 16 + hd]; } while (0)
#define SSD_SCAN(buf, R) do { if (tid < 64) { float v_ = R.dt * a_neg; \
        _Pragma("unroll") for (int o_ = 1; o_ < 64; o_ <<= 1) { const float n_ = __shfl_up(v_, o_); if (lane >= o_) v_ += n_; } \
        dts[(buf) * 64 + tid] = R.dt; acum[(buf) * 64 + tid] = v_; eacs[(buf) * 64 + tid] = fexp(v_); } } while (0)
    __syncthreads();
    for (int i = tid; i < 17408 / 16; i += 512) *(LAS u32x4*)(sb_ + i * 16) = (u32x4){0u, 0u, 0u, 0u};
    SSD_LOADG(0, RA); SSD_LOADG(1, RB); SSD_SCAN(0, RA);
    __syncthreads();
    f32x16 sacc = zero16();
#define SSD_BODY(c, R, RN) do { \
        const float* ac = acum + ((c) & 1) * 64; const float* dcur = dts + ((c) & 1) * 64; const float* eac = eacs + ((c) & 1) * 64; \
        *(LAS u32x4*)(cm_ + lrow0 * 272 + lch * 16) = R.cm0; *(LAS u32x4*)(cm_ + (lrow0 + 32) * 272 + lch * 16) = R.cm1; \
        *(LAS u32x4*)(bm_ + lrow0 * 272 + lch * 16) = R.bm0; *(LAS u32x4*)(bm_ + (lrow0 + 32) * 272 + lch * 16) = R.bm1; \
        { const float d = dcur[xrow], de = fexp(ac[63] - ac[xrow]); float f[8], g[8]; unpack8(R.xs, f); \
          _Pragma("unroll") for (int j = 0; j < 8; ++j) { f[j] *= d; g[j] = f[j] * de; } \
          *(LAS u32x4*)(xd_ + xrow * 144 + xch * 16) = pack8(f); *(LAS u32x4*)(xdd_ + xrow * 144 + xch * 16) = pack8(g); } \
        if ((c) + 2 < 32) SSD_LOADG((c) + 2, R); \
        __syncthreads(); \
        f32x16 y = zero16(); int lt = 0, pt = 0; \
        if (wave < 4) { \
            const int st = wave & 1, lt2 = wave >> 1; f32x16 cb = zero16(); \
            _Pragma("unroll") for (int kk = 0; kk < 8; ++kk) cb = MFMA32(lds_frag(bm_ + (32 * st + r) * 272 + (16 * kk + 8 * h) * 2), lds_frag(cm_ + (32 * lt2 + r) * 272 + (16 * kk + 8 * h) * 2), cb); \
            const int l = 32 * lt2 + r; const float al = ac[l]; \
            _Pragma("unroll") for (int g4 = 0; g4 < 4; ++g4) { const int s0 = 32 * st + 8 * g4 + 4 * h; float v[4]; const f32x4 as4 = *(const LAS f32x4*)(ac + s0); \
                _Pragma("unroll") for (int j = 0; j < 4; ++j) { const int s_ = s0 + j; v[j] = (s_ <= l) ? cb[4 * g4 + j] * fexp(al - as4[j]) : 0.f; } \
                u32x2 w; w.x = pk(v[0], v[1]); w.y = pk(v[2], v[3]); *(LAS u32x2*)(mm_ + l * 144 + s0 * 2) = w; } \
        } else { \
            lt = (wave - 4) >> 1; pt = (wave - 4) & 1; \
            _Pragma("unroll") for (int kk = 0; kk < 8; ++kk) y = MFMA32(lds_frag(cm_ + (32 * lt + r) * 272 + (16 * kk + 8 * h) * 2), lds_frag(sb_ + (32 * pt + r) * 272 + (16 * kk + 8 * h) * 2), y); \
            _Pragma("unroll") for (int g4 = 0; g4 < 4; ++g4) { const f32x4 e4 = *(const LAS f32x4*)(eac + 32 * lt + 8 * g4 + 4 * h); \
                _Pragma("unroll") for (int j = 0; j < 4; ++j) y[4 * g4 + j] *= e4[j]; } \
        } \
        __syncthreads(); \
        if ((c) + 1 < 32) SSD_SCAN(((c) + 1) & 1, RN); \
        if (wave >= 4) { \
            _Pragma("unroll") for (int kk = 0; kk < 4; ++kk) y = MFMA32(lds_frag(mm_ + (32 * lt + r) * 144 + (16 * kk + 8 * h) * 2), frag_tr(xd_, 144, 16 * kk, 32 * pt, lane), y); \
            { const unsigned voff = (unsigned)(((dir ? 4 - 4 * h : 4 * h) * 1024 + r) * 2); const int tb = dir ? (SEQ - 1 - 64 * (c) - 32 * lt - 4) : (64 * (c) + 32 * lt); \
              _Pragma("unroll") for (int i = 0; i < 16; ++i) { const int k_ = (i & 3) + 8 * (i >> 2); const int trow = dir ? tb - k_ : tb + k_; \
                char* ub = (char*)(yout + (size_t)(tokbase + trow) * 1024 + hd * 64 + 32 * pt); *(u16*)(ub + voff) = f2bf(y[i]); } } \
        } \
        { \
            const int nt = wave >> 1, pt2 = wave & 1; const float cd = fexp(ac[63]); \
            _Pragma("unroll") for (int i = 0; i < 16; ++i) sacc[i] *= cd; \
            _Pragma("unroll") for (int kk = 0; kk < 4; ++kk) sacc = MFMA32(frag_tr(bm_, 272, 16 * kk, 32 * nt, lane), frag_tr(xdd_, 144, 16 * kk, 32 * pt2, lane), sacc); \
            const int pp = 32 * pt2 + r; \
            _Pragma("unroll") for (int g4 = 0; g4 < 4; ++g4) { u32x2 w; w.x = pk(sacc[4 * g4], sacc[4 * g4 + 1]); w.y = pk(sacc[4 * g4 + 2], sacc[4 * g4 + 3]); \
                *(LAS u32x2*)(sb_ + pp * 272 + (32 * nt + 8 * g4 + 4 * h) * 2) = w; } \
        } \
        __syncthreads(); } while (0)
#pragma unroll 1
    for (int c = 0; c < 32; c += 2) { SSD_BODY(c, RA, RB); SSD_BODY(c + 1, RB, RA); }
#undef SSD_BODY
#undef SSD_TOK
#undef SSD_LOADG
#undef SSD_SCAN
}

DI u16* gla_img(char* ws, int which) { return (u16*)(ws + OFF_AD) + 512 + (size_t)which * TG * 1024; }
DI void gla_prep_task(char* shm, const Params& p, int layer, char* grp, int task) {
    const int b = task >> 8, c = (task >> 3) & 31, hd = (task >> 1) & 3, dir = task & 1, tokbase = b * SEQ;
    const int tid = opaque(threadIdx.x), kc = tid & 63, sg = tid >> 6, lrow0 = tid >> 4, lrr = tid & 15;
    float* gl_ = (float*)shm; float* seg_ = gl_ + 1024;
    const u16* u = (const u16*)(grp + G_U); const float* glr = (const float*)(grp + G_GLR);
#define GLA_TOK(tau) ((size_t)(tokbase + (dir ? SEQ - 1 - (tau) : (tau))))
    __syncthreads();
    gl_[tid] = glr[GLA_TOK(64 * c + lrow0) * 32 + dir * 16 + lrr]; gl_[tid + 512] = glr[GLA_TOK(64 * c + lrow0 + 32) * 32 + dir * 16 + lrr];
    float wreg[16]; float bgk;
    { const float* wg = p.in[13] + ((size_t)(layer * 2 + dir) * 16) * 256 + hd * 64;
#pragma unroll
      for (int rr = 0; rr < 16; ++rr) wreg[rr] = wg[rr * 256 + kc];
      bgk = p.in[14][(layer * 2 + dir) * 256 + hd * 64 + kc]; }
    u16 qv[8], kv[8];
#pragma unroll
    for (int i = 0; i < 8; ++i) { const size_t t = GLA_TOK(64 * c + 8 * sg + i); qv[i] = u[t * UW + U_QC + hd * 64 + kc]; kv[i] = u[t * UW + U_KC + hd * 64 + kc]; }
    __syncthreads();
    float gc[8]; float run = 0.f;
#pragma unroll
    for (int i = 0; i < 8; ++i) { const int l = 8 * sg + i; float pre = bgk;
#pragma unroll
        for (int q4 = 0; q4 < 4; ++q4) { const f32x4 gv = *(const LAS f32x4*)(gl_ + l * 16 + 4 * q4); pre += gv[0] * wreg[4 * q4] + gv[1] * wreg[4 * q4 + 1] + gv[2] * wreg[4 * q4 + 2] + gv[3] * wreg[4 * q4 + 3]; }
        const float lg = (fminf(pre, 0.f) - 0.6931471805599453f * __builtin_amdgcn_logf(1.f + fexp(-fabsf(pre)))) * (1.f / 16.f); run += lg; gc[i] = run; }
    seg_[sg * 64 + kc] = run;
    __syncthreads();
    float off = 0.f, tot = 0.f;
#pragma unroll
    for (int s2 = 0; s2 < 8; ++s2) { const float v = seg_[s2 * 64 + kc]; tot += v; if (s2 < sg) off += v; }
    u16* qg = gla_img(p.ws, 0); u16* kg = gla_img(p.ws, 1); u16* ke = gla_img(p.ws, 2);
#pragma unroll
    for (int i = 0; i < 8; ++i) { const float g = gc[i] + off; const float qf_ = bf2f(qv[i]), kf_ = bf2f(kv[i]);
        const size_t o = GLA_TOK(64 * c + 8 * sg + i) * 1024 + dir * 256 + hd * 64 + kc;
        qg[o] = f2bf(qf_ * 0.125f * fexp(g)); kg[o] = f2bf(kf_ * fexp(-g)); ke[o] = f2bf(kf_ * fexp(tot - g)); }
    if (sg == 0) ((float*)(p.ws + OFF_GDEC))[(size_t)task * 64 + kc] = fexp(tot);
#undef GLA_TOK
}
DI void gla_item(char* shm, const Params& p, int layer, char* grp, int item) {
    const int b = item >> 3, hd = (item >> 1) & 3, dir = item & 1, tokbase = b * SEQ;
    const int tid = opaque(threadIdx.x), lane = tid & 63, wave = __builtin_amdgcn_readfirstlane(tid >> 6), r = lane & 31, h = lane >> 5;
    char* qg_ = shm; char* kg_ = shm + 9216; char* ke_ = shm + 18432; char* v_ = shm + 27648; char* att_ = shm + 45056; char* sbt_ = shm + 54272;
    float* g63_ = (float*)(shm + 72704);
    const u16* u = (const u16*)(grp + G_U);
    const u16* qgi = gla_img(p.ws, 0) + dir * 256 + hd * 64; const u16* kgi = gla_img(p.ws, 1) + dir * 256 + hd * 64; const u16* kei = gla_img(p.ws, 2) + dir * 256 + hd * 64;
    const float* gdec = (const float*)(p.ws + OFF_GDEC);
    u16* oout = (u16*)(grp + (dir ? G_OB : G_OF));
    const int lrow0 = tid >> 4, lrr = tid & 15, xrow = tid >> 3, xch = tid & 7;
    struct GlaRegs { u32x4 v0, v1, qg, kg, ke; float dec; };
    GlaRegs RA, RB; RA.dec = 0.f; RB.dec = 0.f;
#define GLA_TOK(tau) ((size_t)(tokbase + (dir ? SEQ - 1 - (tau) : (tau))))
#define GLA_LOADG(c, R) do { const size_t t0_ = GLA_TOK(64 * (c) + lrow0), t1_ = GLA_TOK(64 * (c) + lrow0 + 32), tx_ = GLA_TOK(64 * (c) + xrow); \
        R.v0 = *(const u32x4*)(u + t0_ * UW + U_VC + hd * 128 + lrr * 8); R.v1 = *(const u32x4*)(u + t1_ * UW + U_VC + hd * 128 + lrr * 8); \
        R.qg = __builtin_nontemporal_load((const u32x4*)(qgi + tx_ * 1024 + xch * 8)); R.kg = __builtin_nontemporal_load((const u32x4*)(kgi + tx_ * 1024 + xch * 8)); R.ke = __builtin_nontemporal_load((const u32x4*)(kei + tx_ * 1024 + xch * 8)); \
        if (tid < 64) R.dec = gdec[(size_t)((((b * 32 + (c)) * 4 + hd) * 2) + dir) * 64 + tid]; } while (0)
    __syncthreads();
    for (int i = tid; i < 18432 / 16; i += 512) *(LAS u32x4*)(sbt_ + i * 16) = (u32x4){0u, 0u, 0u, 0u};
    GLA_LOADG(0, RA); GLA_LOADG(1, RB);
    f32x16 sacc = zero16();
#define GLA_BODY(c, R) do { \
        *(LAS u32x4*)(v_ + lrow0 * 272 + lrr * 16) = R.v0; *(LAS u32x4*)(v_ + (lrow0 + 32) * 272 + lrr * 16) = R.v1; \
        *(LAS u32x4*)(qg_ + xrow * 144 + xch * 16) = R.qg; *(LAS u32x4*)(kg_ + xrow * 144 + xch * 16) = R.kg; *(LAS u32x4*)(ke_ + xrow * 144 + xch * 16) = R.ke; \
        if (tid < 64) g63_[tid] = R.dec; \
        if ((c) + 2 < 32) GLA_LOADG((c) + 2, R); \
        __syncthreads(); \
        if (wave < 4) { \
            const int st = wave & 1, lt2 = wave >> 1; f32x16 at = zero16(); \
            _Pragma("unroll") for (int kk = 0; kk < 4; ++kk) at = MFMA32(lds_frag(kg_ + (32 * st + r) * 144 + (16 * kk + 8 * h) * 2), lds_frag(qg_ + (32 * lt2 + r) * 144 + (16 * kk + 8 * h) * 2), at); \
            const int l = 32 * lt2 + r; \
            _Pragma("unroll") for (int g4 = 0; g4 < 4; ++g4) { const int s0 = 32 * st + 8 * g4 + 4 * h; float v[4]; \
                _Pragma("unroll") for (int j = 0; j < 4; ++j) v[j] = (s0 + j <= l) ? at[4 * g4 + j] : 0.f; \
                u32x2 w; w.x = pk(v[0], v[1]); w.y = pk(v[2], v[3]); *(LAS u32x2*)(att_ + l * 144 + s0 * 2) = w; } \
        } \
        const int lt = wave >> 2, vt = wave & 3; \
        f32x16 o = zero16(); \
        _Pragma("unroll") for (int kk = 0; kk < 4; ++kk) o = MFMA32(lds_frag(qg_ + (32 * lt + r) * 144 + (16 * kk + 8 * h) * 2), lds_frag(sbt_ + (32 * vt + r) * 144 + (16 * kk + 8 * h) * 2), o); \
        __syncthreads(); \
        _Pragma("unroll") for (int kk = 0; kk < 4; ++kk) o = MFMA32(lds_frag(att_ + (32 * lt + r) * 144 + (16 * kk + 8 * h) * 2), frag_tr(v_, 272, 16 * kk, 32 * vt, lane), o); \
        { const unsigned voff = (unsigned)(((dir ? 4 - 4 * h : 4 * h) * 512 + r) * 2); const int tb = dir ? (SEQ - 1 - 64 * (c) - 32 * lt - 4) : (64 * (c) + 32 * lt); \
          _Pragma("unroll") for (int i = 0; i < 16; ++i) { const int k_ = (i & 3) + 8 * (i >> 2); const int trow = dir ? tb - k_ : tb + k_; \
            char* ub = (char*)(oout + (size_t)(tokbase + trow) * 512 + hd * 128 + 32 * vt); *(u16*)(ub + voff) = f2bf(o[i]); } } \
        { \
            const int kt = lt; \
            _Pragma("unroll") for (int i = 0; i < 16; ++i) sacc[i] *= g63_[32 * kt + crow(i, h)]; \
            _Pragma("unroll") for (int kk = 0; kk < 4; ++kk) sacc = MFMA32(frag_tr(ke_, 144, 16 * kk, 32 * kt, lane), frag_tr(v_, 272, 16 * kk, 32 * vt, lane), sacc); \
            const int vv = 32 * vt + r; \
            _Pragma("unroll") for (int g4 = 0; g4 < 4; ++g4) { u32x2 w; w.x = pk(sacc[4 * g4], sacc[4 * g4 + 1]); w.y = pk(sacc[4 * g4 + 2], sacc[4 * g4 + 3]); \
                *(LAS u32x2*)(sbt_ + vv * 144 + (32 * kt + 8 * g4 + 4 * h) * 2) = w; } \
        } \
        __syncthreads(); } while (0)
#pragma unroll 1
    for (int c = 0; c < 32; c += 2) { GLA_BODY(c, RA); GLA_BODY(c + 1, RB); }
#undef GLA_BODY
#undef GLA_TOK
#undef GLA_LOADG
}

DI void post_token(const Params& p, int layer, char* grp, int g, int tg, int lane_in) {
    const int lane = opaque(lane_in);
    const u16* u = (const u16*)(grp + G_U);
    const size_t tglob = (size_t)g * TG + tg;
    { const u16* yf = (const u16*)(grp + G_YF); const u16* yb = (const u16*)(grp + G_YB); const u16* xc = (const u16*)(grp + G_XC);
      u16* aa = (u16*)(p.ws + OFF_AA); const float* ng = p.in[8] + layer * 1024; const float* ds = p.in[7] + layer * 16;
      float v[2][8]; float ss = 0.f;
#pragma unroll
      for (int i = 0; i < 2; ++i) { const int c = lane * 8 + 512 * i; float a[8], bb[8], x[8], z[8];
          unpack8(__builtin_nontemporal_load((const u32x4*)(yf + (size_t)tg * 1024 + c)), a); unpack8(__builtin_nontemporal_load((const u32x4*)(yb + (size_t)tg * 1024 + c)), bb);
          unpack8(*(const u32x4*)(xc + (size_t)tg * 1536 + c), x); unpack8(*(const u32x4*)(u + (size_t)tg * UW + U_ZA + c), z);
          const float dsk = ds[c >> 6];
#pragma unroll
          for (int j = 0; j < 8; ++j) { v[i][j] = (a[j] + bb[j] + x[j] * dsk) * z[j]; ss += v[i][j] * v[i][j]; } }
      ss = wave_sum(ss); const float rstd = rsqrtf(ss * (1.f / 1024.f) + EPS);
#pragma unroll
      for (int i = 0; i < 2; ++i) { const int c = lane * 8 + 512 * i; float o[8];
#pragma unroll
          for (int j = 0; j < 8; ++j) o[j] = v[i][j] * rstd * ng[c + j];
          *(u32x4*)(aa + tglob * 1024 + c) = pack8(o); } }
    { const u16* of = (const u16*)(grp + G_OF); const u16* ob = (const u16*)(grp + G_OB); u16* ac = (u16*)(p.ws + OFF_AC); const float* ng = p.in[15] + layer * 512;
      const int c = lane * 8; float a[8], bb[8], z[8], o[8]; float ss = 0.f;
      unpack8(__builtin_nontemporal_load((const u32x4*)(of + (size_t)tg * 512 + c)), a); unpack8(__builtin_nontemporal_load((const u32x4*)(ob + (size_t)tg * 512 + c)), bb); unpack8(*(const u32x4*)(u + (size_t)tg * UW + U_ZC + c), z);
#pragma unroll
      for (int j = 0; j < 8; ++j) { a[j] += bb[j]; ss += a[j] * a[j]; }
      ss += __shfl_xor(ss, 1); ss += __shfl_xor(ss, 2); ss += __shfl_xor(ss, 4); ss += __shfl_xor(ss, 8);
      const float rstd = rsqrtf(ss * (1.f / 128.f) + EPS);
#pragma unroll
      for (int j = 0; j < 8; ++j) o[j] = a[j] * rstd * ng[c + j] * z[j];
      *(u32x4*)(ac + tglob * 1024 + c) = pack8(o); }
}

__global__ void __launch_bounds__(512) mega(Params p) {
    extern __shared__ __attribute__((aligned(16))) char shm[];
    cg::grid_group grid = cg::this_grid();
    LAS unsigned char* lds = (LAS unsigned char*)shm;
    const int G = gridDim.x, bx = blockIdx.x;
    char* ws = p.ws; char* grp = ws + OFF_GRP;
    volatile LAS unsigned* xst = (volatile LAS unsigned*)(lds + STAGE_BYTES + 2048);
    if (threadIdx.x == 0) { xst[0] = 0u; xst[1] = 0u; }
    __syncthreads();
    const XcdBarrier xbar = xcd_barrier_post((unsigned*)(ws + OFF_BAR), xst);
#define GSYNC() xcd_barrier(xbar)
#pragma unroll 1
    for (int layer = 0; layer < 2; ++layer) {
        const float* xin = layer == 0 ? p.in[0] : p.out;
        phase_weights(shm, p, layer);
        phase_rownorm<false>(xin, p.in[1] + layer * 1024, (u16*)(ws + OFF_HB), nullptr);
        if (p.out == nullptr) grid.sync();
        GSYNC();
#pragma unroll 1
        for (int g = 0; g < NGROUP; ++g) {
            { pg8::Gemm gm{(const u16*)(ws + OFF_HB) + (size_t)g * TG * 1024, 1024, (const u16*)(ws + OFF_WALL) + (size_t)4096 * 1024, 1024, 1024};
              pg8::Strided S{gm, TG / 256, 16, bx, G, 0, gm.lda, gm.ldb};
              pg8::EpiInproj E{(u16*)(grp + G_U), (float*)(grp + G_DTRAW), (float*)(grp + G_GLR)};
              pg8::gemm_phase(lds, S, E); }
            GSYNC();
            { { pg8::Gemm gm{(const u16*)(ws + OFF_HB) + (size_t)g * TG * 1024, 1024, (const u16*)(ws + OFF_WALL) + (size_t)4096 * 1024, 1024, 1024};
                pg8::Strided S{gm, TG / 256, 4, bx, G, -1, gm.lda, gm.ldb};
                pg8::EpiInproj E{(u16*)(grp + G_U), (float*)(grp + G_DTRAW), (float*)(grp + G_GLR)};
                pg8::gemm_phase(lds, S, E); }
              unsigned* ctr = (unsigned*)(ws + OFF_CTR) + 16 + layer * 4 + g; volatile int* slot = (volatile int*)(shm + STAGE_BYTES + 2064);
              const int ngla = GSEQ * 32 * 4 * 2, nq = 32 * 3, nkv = 32 * 4, nconv = (TG / 16) * 3 / 8, ntok = TG / 32;
#pragma unroll 1
              for (;;) {
                __syncthreads();
                if (threadIdx.x == 0) *slot = (int)atomicAdd(ctr, 1u);
                __syncthreads();
                const int it0 = __builtin_amdgcn_readfirstlane(*slot);
                if (it0 >= ngla + nq + nkv + nconv + ntok) break;
                if (it0 < ngla) { gla_prep_task(shm, p, layer, grp, it0); continue; }
                const int it = it0 - ngla;
                if (it < nq) { const int pm = it / 3, pn = it % 3; rowstat<384>(shm, (const u16*)(grp + G_U) + U_QLAT, UW, pm * 256);
                  pg8::Gemm gm{(const u16*)(grp + G_U) + U_QLAT, UW, (const u16*)(ws + OFF_WQ), 384, 384}; pg8::OneUnit S{gm, pm, pn, gm.lda, gm.ldb};
                  pg8::EpiQ E{(u16*)(grp + G_QM), (const LAS float*)(shm + STAGE_BYTES)}; pg8::gemm_phase(lds, S, E); }
                else if (it < nq + nkv) { const int t = it - nq, pm = t >> 2, pn = t & 3; rowstat<256>(shm, (const u16*)(grp + G_U) + U_KVLAT, UW, pm * 256);
                  pg8::Gemm gm{(const u16*)(grp + G_U) + U_KVLAT, UW, (const u16*)(ws + OFF_WKV), 256, 256}; pg8::OneUnit S{gm, pm, pn, gm.lda, gm.ldb};
                  pg8::EpiKV E{(u16*)(grp + G_KM), (u16*)(grp + G_VM), (const LAS float*)(shm + STAGE_BYTES)}; pg8::gemm_phase(lds, S, E); }
                else { const int t_ = opaque(threadIdx.x); const int wave = __builtin_amdgcn_readfirstlane(t_ >> 6);
                  if (it < nq + nkv + nconv) conv_task(p, layer, grp, (it - nq - nkv) * 8 + wave, t_ & 63);
                  else prep_tokens<4>(p, layer, grp, (it - nq - nkv - nconv) * 32 + wave * 4, 1, t_ & 63); }
              } }
            GSYNC();
            { unsigned* ctr = (unsigned*)(ws + OFF_CTR) + layer * 4 + g; volatile int* slot = (volatile int*)(shm + STAGE_BYTES + 2064);
#pragma unroll 1
              for (;;) {
                __syncthreads();
                if (threadIdx.x == 0) *slot = (int)atomicAdd(ctr, 1u);
                __syncthreads();
                const int it = __builtin_amdgcn_readfirstlane(*slot);
                if (it >= 32 + 128 + 256 + 256 + 192) break;
                if (it < 32) gla_item(shm, p, layer, grp, it);
                else if (it < 160) ssd_item(shm, p, layer, grp, it - 32);
                else if (it < 416) { const int a = it - 160, b = a >> 6, hd = (a >> 3) & 7, qb = a & 7;
                    attn_item<96, true>(shm, (const u16*)(grp + G_QM) + hd * 96, 768, (const u16*)(grp + G_KM) + hd * 96, 768, (const u16*)(grp + G_VM) + hd * 64, 512,
                                        (const u16*)(grp + G_U) + U_ZB + hd * 64, UW, (u16*)(ws + OFF_AB) + (size_t)g * TG * 1024 + hd * 64, 1024, b * SEQ, qb * 256, 0.10206207261596577f); }
                else if (it >= 672) { const int zi = it - 672, pm = zi / 6, pl = zi % 6, pn = (pl < 4) ? 16 + pl : 18 + pl;
                    pg8::Gemm gm{(const u16*)(ws + OFF_HB) + (size_t)g * TG * 1024, 1024, (const u16*)(ws + OFF_WALL) + (size_t)4096 * 1024, 1024, 1024};
                    pg8::OneUnit S{gm, pm, pn, gm.lda, gm.ldb}; pg8::EpiInproj E{(u16*)(grp + G_U), (float*)(grp + G_DTRAW), (float*)(grp + G_GLR)};
                    pg8::gemm_phase(lds, S, E); }
                else { const int a = it - 416, b = a >> 6, hd = (a >> 3) & 7, qb = a & 7, kvh = hd >> 2;
                    attn_item<64, false>(shm, (const u16*)(grp + G_QG) + hd * 64, 512, (const u16*)(grp + G_KG) + kvh * 64, 128, (const u16*)(grp + G_U) + U_VD + kvh * 64, UW,
                                         (const u16*)(grp + G_U) + U_ZD + hd * 64, UW, (u16*)(ws + OFF_AD) + (size_t)g * TG * 1024 + hd * 64, 1024, b * SEQ, qb * 256, 0.125f); }
              } }
            GSYNC();
            { const int t_ = opaque(threadIdx.x); const int wave = __builtin_amdgcn_readfirstlane(t_ >> 6);
                for (int tg = bx * 8 + wave; tg < TG; tg += G * 8) post_token(p, layer, grp, g, tg, t_ & 63); }
            if (g == NGROUP - 1) GSYNC();
        }
        { u16* sgp = (u16*)(grp + P5_SCR + (size_t)bx * P5_SCR_PER); float* saccp = (float*)(grp + P5_SCR + (size_t)bx * P5_SCR_PER + 256 * 256 * 2);
          pg8::P5Sched S{ws, bx, G, 1024, 1024}; pg8::EpiP5 E{sgp, saccp, (u16*)(grp + P5_MIXED)};
          pg8::gemm_phase(lds, S, E); }
        GSYNC();
        { pg8::Gemm gm{(const u16*)(grp + P5_MIXED), 1024, (const u16*)(ws + OFF_WO), 1024, 1024}; pg8::Strided S{gm, 128, 4, bx, G, 0, gm.lda, gm.ldb};
          pg8::EpiOut E{xin, p.out}; pg8::gemm_phase(lds, S, E); }
        GSYNC();
    }
    phase_rownorm<true>(p.out, p.in[23], nullptr, p.out);
}

extern "C" void kernel_launch(void* const* d_in, const int* in_sizes, int n_in, void* d_out, int out_size, void* d_ws, size_t ws_size, hipStream_t stream) {
    static int grid_blocks = 0;
    if (grid_blocks == 0) {
        if (n_in != 24 || ws_size < WS_NEED) { fprintf(stderr, "kernel_launch: need 24 inputs and %zu bytes of workspace, got %d / %zu\n", (size_t)WS_NEED, n_in, ws_size); grid_blocks = -1; return; }
        int dev = 0, cus = 0, per_cu = 0;
        hipGetDevice(&dev);
        hipDeviceGetAttribute(&cus, hipDeviceAttributeMultiprocessorCount, dev);
        if (hipFuncSetAttribute((const void*)mega, hipFuncAttributeMaxDynamicSharedMemorySize, LDS_BYTES) != hipSuccess) { fprintf(stderr, "kernel_launch: hipFuncSetAttribute failed\n"); grid_blocks = -1; return; }
        hipOccupancyMaxActiveBlocksPerMultiprocessor(&per_cu, (const void*)mega, 512, LDS_BYTES);
        if (per_cu < 1) { fprintf(stderr, "kernel_launch: occupancy query says 0 blocks per CU\n"); per_cu = 1; }
        grid_blocks = cus * per_cu;
        if (grid_blocks > MAX_GRID) grid_blocks = MAX_GRID;
        grid_blocks &= ~7;
    }
    if (grid_blocks <= 0) return;
    if (hipMemsetAsync((char*)d_ws + OFF_CTR, 0, 4096 + 16384, stream) != hipSuccess) { fprintf(stderr, "kernel_launch: memset failed\n"); return; }
    Params p{};
    for (int i = 0; i < 24; ++i) p.in[i] = (const float*)d_in[i];
    p.out = (float*)d_out; p.ws = (char*)d_ws;
    void* args[] = {&p};
    hipError_t e = hipLaunchCooperativeKernel((const void*)mega, dim3(grid_blocks), dim3(512), args, LDS_BYTES, stream);
    if (e != hipSuccess) fprintf(stderr, "cooperative launch failed: %s (grid %d)\n", hipGetErrorString(e), grid_blocks);
}
```

```cpp
#include <hip/hip_runtime.h>
#include <hip/hip_cooperative_groups.h>
#include <cstdio>
namespace cg = cooperative_groups;

#define DI __device__ __forceinline__
#define LAS __attribute__((address_space(3)))
typedef unsigned short u16;
typedef short bf16x8 __attribute__((ext_vector_type(8)));
typedef short s16x4 __attribute__((ext_vector_type(4)));
typedef float f32x2 __attribute__((ext_vector_type(2)));
typedef float f32x4 __attribute__((ext_vector_type(4)));
typedef float f32x16 __attribute__((ext_vector_type(16)));
typedef unsigned u32x2 __attribute__((ext_vector_type(2)));
typedef unsigned u32x4 __attribute__((ext_vector_type(4)));
typedef __bf16 bf16x2_t __attribute__((ext_vector_type(2)));

constexpr int T_ALL = 32768, SEQ = 2048, DM = 1024;
constexpr int GSEQ = 4, TG = GSEQ * SEQ, NGROUP = 16 / GSEQ;
constexpr int NIN = 10720, UW = 6656;
constexpr int U_XBC = 0, U_DT = 1536, U_QLAT = 1568, U_KVLAT = 1952, U_KROPE = 2208, U_QD = 2240, U_KD = 2752, U_GLR = 2880,
              U_VD = 2912, U_QC = 3040, U_KC = 3296, U_VC = 3552, U_PAD = 4064, U_ZA = 4096, U_ZB = 5120, U_ZC = 5632, U_ZD = 6144;
DI int ucol_of(int j) {
    if (j < 1024) return U_ZA + j;
    if (j < 2560) return U_XBC + (j - 1024);
    if (j < 2592) return U_DT + (j - 2560);
    if (j < 3104) return U_ZB + (j - 2592);
    if (j < 3488) return U_QLAT + (j - 3104);
    if (j < 3744) return U_KVLAT + (j - 3488);
    if (j < 3776) return U_KROPE + (j - 3744);
    if (j < 4288) return U_ZC + (j - 3776);
    if (j < 4544) return U_QC + (j - 4288);
    if (j < 4800) return U_KC + (j - 4544);
    if (j < 5312) return U_VC + (j - 4800);
    if (j < 5344) return U_GLR + (j - 5312);
    if (j < 5856) return U_ZD + (j - 5344);
    if (j < 6368) return U_QD + (j - 5856);
    if (j < 6496) return U_KD + (j - 6368);
    return U_VD + (j - 6496);
}
constexpr float EPS = 1e-6f;
constexpr float LOG2E = 1.4426950408889634f;

constexpr size_t OFF_WALL = 0;
constexpr size_t OFF_WQ = OFF_WALL + (size_t)10752 * 1024 * 2;
constexpr size_t OFF_WKV = OFF_WQ + (size_t)768 * 384 * 2;
constexpr size_t OFF_WA = OFF_WKV + (size_t)1024 * 256 * 2;
constexpr size_t OFF_WB = OFF_WA + (size_t)1024 * 1024 * 2;
constexpr size_t OFF_WC = OFF_WB + (size_t)1024 * 1024 * 2;
constexpr size_t OFF_WD = OFF_WC + (size_t)1024 * 1024 * 2;
constexpr size_t OFF_WO = OFF_WD + (size_t)1024 * 1024 * 2;
constexpr size_t OFF_HB = OFF_WO + (size_t)1024 * 1024 * 2;
constexpr size_t OFF_AA = OFF_HB + (size_t)T_ALL * 1024 * 2;
constexpr size_t OFF_AB = OFF_AA + (size_t)T_ALL * 1024 * 2;
constexpr size_t OFF_AC = OFF_AB + 512 * 2;
constexpr size_t OFF_AD = OFF_AB + (size_t)T_ALL * 1024 * 2;
constexpr size_t OFF_GRP = OFF_AD + (size_t)T_ALL * 1024 * 2;
constexpr size_t G_U = 0;
constexpr size_t G_DTRAW = G_U + (size_t)TG * UW * 2;
constexpr size_t G_GLR = G_DTRAW + (size_t)TG * 32 * 4;
constexpr size_t G_DTV = G_GLR + (size_t)TG * 32 * 4;
constexpr size_t G_XC = G_DTV + (size_t)TG * 32 * 4;
constexpr size_t G_QM = G_XC + (size_t)TG * 1536 * 2;
constexpr size_t G_KM = G_QM + (size_t)TG * 768 * 2;
constexpr size_t G_VM = G_KM + (size_t)TG * 768 * 2;
constexpr size_t G_QG = G_VM + (size_t)TG * 512 * 2;
constexpr size_t G_KG = G_QG + (size_t)TG * 512 * 2;
constexpr size_t G_YF = G_KG + (size_t)TG * 128 * 2;
constexpr size_t G_YB = G_YF + (size_t)TG * 1024 * 2;
constexpr size_t G_OF = G_YB + (size_t)TG * 1024 * 2;
constexpr size_t G_OB = G_OF + (size_t)TG * 512 * 2;
constexpr size_t G_END = G_OB + (size_t)TG * 512 * 2;
constexpr size_t P5_MIXED = 0;
constexpr size_t P5_SCR = (size_t)T_ALL * 1024 * 2;
constexpr size_t P5_SCR_PER = (size_t)256 * 256 * 2 + (size_t)256 * 256 * 4;
constexpr int MAX_GRID = 256;
static_assert(P5_SCR + MAX_GRID * P5_SCR_PER <= G_END, "p5 scratch must fit the group area");
constexpr size_t OFF_CTR = OFF_GRP + G_END;
constexpr size_t OFF_BAR = OFF_CTR + 4096;
constexpr size_t OFF_GDEC = OFF_BAR + 16384;
constexpr size_t WS_NEED = OFF_GDEC + (size_t)GSEQ * 32 * 4 * 2 * 64 * 4;
static_assert(WS_NEED <= (size_t)536870912, "workspace budget");

constexpr int STAGE_BYTES = 131072;
constexpr int LDS_BYTES = STAGE_BYTES + 2048 + 64;

struct Params {
    const float* in[24];
    float* out; char* ws;
};

DI unsigned pk(float a, float b) { f32x2 v = {a, b}; bf16x2_t r = __builtin_convertvector(v, bf16x2_t); return __builtin_bit_cast(unsigned, r); }
DI u16 f2bf(float a) { return (u16)(pk(a, 0.f) & 0xffffu); }
DI float bflo(unsigned w) { return __uint_as_float(w << 16); }
DI float bfhi(unsigned w) { return __uint_as_float(w & 0xffff0000u); }
DI float bf2f(u16 b) { return __uint_as_float(((unsigned)b) << 16); }
DI float sigmf(float v) { return __builtin_amdgcn_rcpf(1.f + __builtin_amdgcn_exp2f(-v * 1.4426950408889634f)); }
DI float siluf(float v) { return v * sigmf(v); }
DI float softplusf(float v) { return fmaxf(v, 0.f) + log1pf(__expf(-fabsf(v))); }
DI float fexp2(float v) { return __builtin_amdgcn_exp2f(v); }
DI float fexp(float v) { return __builtin_amdgcn_exp2f(v * LOG2E); }
DI int opaque(int v) { asm volatile("" : "+v"(v)); return v; }
DI int crow(int i, int h) { return (i & 3) + 8 * (i >> 2) + 4 * h; }
#define MFMA32(a, b, c) __builtin_amdgcn_mfma_f32_32x32x16_bf16((a), (b), (c), 0, 0, 0)
DI void unpack8(const u32x4 w, float* f) { f[0] = bflo(w.x); f[1] = bfhi(w.x); f[2] = bflo(w.y); f[3] = bfhi(w.y); f[4] = bflo(w.z); f[5] = bfhi(w.z); f[6] = bflo(w.w); f[7] = bfhi(w.w); }
DI u32x4 pack8(const float* f) { u32x4 w; w.x = pk(f[0], f[1]); w.y = pk(f[2], f[3]); w.z = pk(f[4], f[5]); w.w = pk(f[6], f[7]); return w; }
DI void sincos_rope(float ang, float& c, float& s) { const float rev = ang * 0.15915494309189535f; const float fr = rev - floorf(rev); c = __builtin_amdgcn_cosf(fr); s = __builtin_amdgcn_sinf(fr); }
DI f32x16 zero16() { f32x16 z;
#pragma unroll
    for (int i = 0; i < 16; ++i) z[i] = 0.f; return z; }
DI bf16x8 frag_tr(const char* base, int pitch, int k0, int m0, int lane) {
    const int i16 = lane & 15, q = i16 >> 2, p = i16 & 3, blk = (lane >> 4) & 1, h = lane >> 5;
    const char* a = base + (k0 + 8 * h + q) * pitch + (m0 + 16 * blk + 4 * p) * 2;
    const s16x4 lo = __builtin_amdgcn_ds_read_tr16_b64_v4i16((LAS s16x4*)a);
    const s16x4 hi = __builtin_amdgcn_ds_read_tr16_b64_v4i16((LAS s16x4*)(a + 4 * pitch));
    return __builtin_shufflevector(lo, hi, 0, 1, 2, 3, 4, 5, 6, 7);
}
DI bf16x8 lds_frag(const char* p) { return *(const LAS bf16x8*)p; }


#define XB_TMO      128
#define XB_XCNT(j)  (256  + 64 * (j))
#define XB_XSUB(j)  (1280 + 64 * (j))
#define XB_XGEN(j)  (2304 + 64 * (j))
#define XB_TOP      3328
#define XB_TOPGEN   3392
#define XB_SPIN_CAP (1u << 22)
DI unsigned xb_ld(unsigned* p) { return __hip_atomic_load(p, __ATOMIC_RELAXED, __HIP_MEMORY_SCOPE_AGENT); }
DI unsigned xb_add(unsigned* p, unsigned v) { return __hip_atomic_fetch_add(p, v, __ATOMIC_RELAXED, __HIP_MEMORY_SCOPE_AGENT); }
DI unsigned xb_xcc_id() { return (unsigned)__builtin_amdgcn_s_getreg((3 << 11) | 20) & 0xFu; }
#define XB_SPIN(cond, bar) do { unsigned _sp = 0; while (cond) { __builtin_amdgcn_s_sleep(1); \
    if ((++_sp & 255u) == 0u) { if (xb_ld(&(bar)[XB_TMO])) break; if (_sp > XB_SPIN_CAP) { atomicAdd(&(bar)[XB_TMO], 1u); break; } } } } while (0)
struct XcdBarrier { unsigned* bar; unsigned x; volatile LAS unsigned* st; };
DI XcdBarrier xcd_barrier_post(unsigned* bar, volatile LAS unsigned* st) {
    XcdBarrier b; b.bar = bar; b.x = xb_xcc_id(); b.st = st;
    if (threadIdx.x == 0) (void)xb_add(&bar[XB_XCNT(b.x)], 1u);
    return b;
}
DI void xcd_barrier_complete(unsigned* bar, unsigned x, unsigned& nloc, unsigned& nx) {
    const unsigned G = gridDim.x * gridDim.y * gridDim.z;
    unsigned sum, cnt, mine, sp = 0u;
    for (;;) {
        sum = 0u; cnt = 0u; mine = 0u;
#pragma unroll
        for (unsigned j = 0; j < 16; ++j) { const unsigned c = xb_ld(&bar[XB_XCNT(j)]); sum += c; cnt += (c > 0u) ? 1u : 0u; mine = (j == x) ? c : mine; }
        if (sum == G) break;
        __builtin_amdgcn_s_sleep(1);
        if ((++sp & 255u) == 0u) { if (xb_ld(&bar[XB_TMO])) break; if (sp > XB_SPIN_CAP) { atomicAdd(&bar[XB_TMO], 1u); break; } }
    }
    nloc = mine > 0u ? mine : 1u; nx = cnt > 0u ? cnt : 1u;
}
DI void xcd_barrier(const XcdBarrier& b) {
    asm volatile("s_waitcnt vmcnt(0)" ::: "memory");
    __syncthreads();
    if (threadIdx.x == 0) {
        unsigned* bar = b.bar;
        __builtin_amdgcn_s_waitcnt(0);
        unsigned nloc = b.st[0], nx = b.st[1];
        if (nloc == 0u) { xcd_barrier_complete(bar, b.x, nloc, nx); b.st[0] = nloc; b.st[1] = nx; }
        const unsigned old = xb_add(&bar[XB_XSUB(b.x)], 1u);
        const unsigned gen = old / nloc;
        if (old + 1u == (gen + 1u) * nloc) {
            __builtin_amdgcn_fence(__ATOMIC_RELEASE, "agent");
            asm volatile("s_waitcnt vmcnt(0)" ::: "memory");
            const unsigned og = xb_add(&bar[XB_TOP], 1u);
            const unsigned tg = og / nx;
            if (og + 1u == (tg + 1u) * nx) xb_add(&bar[XB_TOPGEN], 1u);
            else XB_SPIN(xb_ld(&bar[XB_TOPGEN]) == tg, bar);
            __builtin_amdgcn_fence(__ATOMIC_ACQUIRE, "agent");
            xb_add(&bar[XB_XGEN(b.x)], 1u);
            asm volatile("s_waitcnt vmcnt(0)" ::: "memory");
        } else {
            XB_SPIN(xb_ld(&bar[XB_XGEN(b.x)]) == gen, bar);
            __builtin_amdgcn_fence(__ATOMIC_ACQUIRE, "agent");
            asm volatile("s_waitcnt vmcnt(0)" ::: "memory");
        }
    }
    __syncthreads();
}

namespace pg8 {
constexpr int BM = 256, BK = 64, HALF = 128, HTB = HALF * BK * 2, NXCD = 8, WGM = 8;
DI int lds_byte(int r, int c) { const int st = (r >> 4) * 2 + (c >> 5), rr = r & 15, cc = c & 31, ob = rr * 64 + cc * 2; return st * 1024 + (ob ^ (((ob >> 9) & 1) << 5)); }
DI void stage_rc(int b, int& R, int& C) { const int st = b / 1024, sb = b % 1024, swz = sb ^ (((sb >> 9) & 1) << 5); R = (st >> 1) * 16 + swz / 64; C = (st & 1) * 32 + (swz % 64) / 2; }
DI int perm32(int rho) { const int n = rho >> 4, i = rho & 15; return 8 * (i >> 2) + 4 * n + (i & 3); }
struct Unit { int pm, pn; const u16* A; const u16* Bt; int nt, tag; };
DI void tile_map(int L, int nM, int nN, Unit& u) {
    const int nwg = nM * nN; int wgid = L;
    { const int q = nwg / NXCD, r = nwg % NXCD, xcd = wgid % NXCD, off = wgid / NXCD; wgid = (xcd < r ? xcd * (q + 1) : r * (q + 1) + (xcd - r) * q) + off; }
    const int nig = WGM * nN, gid = wgid / nig, fm = gid * WGM, gsz = (nM - fm) < WGM ? (nM - fm) : WGM;
    u.pm = fm + ((wgid % nig) % gsz); u.pn = (wgid % nig) / gsz;
}
struct Gemm { const u16* A; int lda; const u16* Bt; int ldb; int K; };
struct Strided { Gemm g; int nM, nN, first, stride, pn0; int lda, ldb;
    DI bool next(int i, Unit& u) const { const int L = first + i * stride; if (L >= nM * nN) return false; tile_map(L, nM, nN, u); u.pn = (pn0 >= 0) ? u.pn + pn0 : ((u.pn < 2 ? 20 : 22) + u.pn);
        u.A = g.A; u.Bt = g.Bt; u.nt = g.K / BK; u.tag = 0; return true; } };
struct OneUnit { Gemm g; int pm, pn; int lda, ldb;
    DI bool next(int i, Unit& u) const { if (i != 0) return false; u.pm = pm; u.pn = pn; u.A = g.A; u.Bt = g.Bt; u.nt = g.K / BK; u.tag = 0; return true; } };

template <class Epi, class Sched>
DI void gemm_phase(LAS unsigned char* lds, const Sched& S, const Epi& E) {
    const int tid = opaque(threadIdx.x), wid = __builtin_amdgcn_readfirstlane(tid >> 6), lane = tid & 63, wr = wid >> 2, wc = wid & 3, fr = lane & 15, fq = lane >> 4;
    const size_t kstep = (size_t)(BK * 2);
    const unsigned ldsw = (unsigned)wid * 1024u;
    const int aoff = lds_byte(wr * 64 + fr, fq * 8), boff = lds_byte(wc * 32 + fr, fq * 8);
#define PG8_SA(b, h) (((b) * 2 + (h)) * HTB)
#define PG8_SB(b, h) ((4 + (b) * 2 + (h)) * HTB)
#define PG8_STAGE(bufoff, gbase, voff) do { _Pragma("unroll") for (int _i = 0; _i < 2; ++_i) \
        __builtin_amdgcn_global_load_lds((const unsigned*)((const char*)(gbase) + (voff)[_i]), (LAS unsigned*)(lds + (bufoff) + ldsw + _i * 8192), 16, 0, 0); } while (0)
#define PG8_LDA(dst, b, h) do { _Pragma("unroll") for (int m = 0; m < 4; ++m) _Pragma("unroll") for (int k = 0; k < 2; ++k) dst[m][k] = *(const LAS bf16x8*)(lds + PG8_SA(b, h) + aoff + m * 2048 + k * 1024); } while (0)
#define PG8_LDB(dst, b, h) do { _Pragma("unroll") for (int n = 0; n < 2; ++n) _Pragma("unroll") for (int k = 0; k < 2; ++k) dst[n][k] = *(const LAS bf16x8*)(lds + PG8_SB(b, h) + boff + n * 2048 + k * 1024); } while (0)
#define PG8_MMA(ai, bj, At, Bt) do { __builtin_amdgcn_s_setprio(1); _Pragma("unroll") for (int m = 0; m < 4; ++m) _Pragma("unroll") for (int n = 0; n < 2; ++n) _Pragma("unroll") for (int k = 0; k < 2; ++k) \
        acc[ai][bj][m][n] = __builtin_amdgcn_mfma_f32_16x16x32_bf16(Bt[n][k], At[m][k], acc[ai][bj][m][n], 0, 0, 0); __builtin_amdgcn_s_setprio(0); } while (0)
#define PG8_WAIT_V(n) asm volatile("s_waitcnt vmcnt(" #n ")" ::: "memory")
#define PG8_WAIT_L(n) asm volatile("s_waitcnt lgkmcnt(" #n ")" ::: "memory")
#define PG8_BAR __builtin_amdgcn_s_barrier()
#define PG8_SCHED __builtin_amdgcn_sched_barrier(0)
    Unit cur, nxt; int ui = 0;
    if (!S.next(0, cur)) return;
    unsigned voffA[2], voffB[2];
#pragma unroll
    for (int i = 0; i < 2; ++i) { int R, C; stage_rc(tid * 16 + i * 8192, R, C); const int Rb = (R & ~31) + perm32(R & 31);
        voffA[i] = (unsigned)(R * S.lda + C) * 2u; voffB[i] = (unsigned)(Rb * S.ldb + C) * 2u; }
    const size_t hstepA = (size_t)HALF * S.lda * 2, hstepB = (size_t)HALF * S.ldb * 2;
    f32x4 acc[2][2][4][2];
#pragma unroll
    for (int a = 0; a < 2; ++a)
#pragma unroll
        for (int b = 0; b < 2; ++b)
#pragma unroll
            for (int m = 0; m < 4; ++m)
#pragma unroll
                for (int n = 0; n < 2; ++n) acc[a][b][m][n] = (f32x4){0.f, 0.f, 0.f, 0.f};
    bf16x8 At[4][2], B0[2][2], B1[2][2];
    const char* cA = (const char*)cur.A + (size_t)cur.pm * 2 * hstepA; const char* cB = (const char*)cur.Bt + (size_t)cur.pn * 2 * hstepB;
    PG8_STAGE(PG8_SB(0, 0), cB, voffB); PG8_STAGE(PG8_SA(0, 0), cA, voffA); PG8_STAGE(PG8_SB(0, 1), cB + hstepB, voffB); PG8_STAGE(PG8_SA(0, 1), cA + hstepA, voffA);
    if (wr == 1) PG8_BAR;
    PG8_WAIT_V(4); PG8_BAR;
    PG8_STAGE(PG8_SB(1, 0), cB + kstep, voffB); PG8_STAGE(PG8_SA(1, 0), cA + kstep, voffA); PG8_STAGE(PG8_SB(1, 1), cB + hstepB + kstep, voffB);
    PG8_WAIT_V(6); PG8_BAR;
    for (;;) {
        const bool has_next = S.next(ui + 1, nxt);
        if (!has_next) nxt = cur;
        const char* nA = (const char*)nxt.A + (size_t)nxt.pm * 2 * hstepA; const char* nB = (const char*)nxt.Bt + (size_t)nxt.pn * 2 * hstepB;
        const int nt = cur.nt;
#pragma unroll 1
        for (int t = 0; t < nt; t += 2) {
            const bool last = (t == nt - 2);
            const char* a1 = cA + (size_t)(t + 1) * kstep;
            const char* a2 = last ? nA : cA + (size_t)(t + 2) * kstep; const char* b2 = last ? nB : cB + (size_t)(t + 2) * kstep;
            const char* a3 = a2 + kstep; const char* b3 = b2 + kstep;
            PG8_LDB(B0, 0, 0); PG8_SCHED; PG8_LDA(At, 0, 0); PG8_STAGE(PG8_SA(1, 1), a1 + hstepA, voffA);
            PG8_WAIT_L(8); PG8_BAR; PG8_WAIT_L(0); PG8_MMA(0, 0, At, B0); PG8_BAR; PG8_SCHED;
            PG8_LDB(B1, 0, 1); PG8_STAGE(PG8_SB(0, 0), b2, voffB);
            PG8_BAR; PG8_WAIT_L(0); PG8_MMA(0, 1, At, B1); PG8_BAR;
            PG8_LDA(At, 0, 1); PG8_STAGE(PG8_SA(0, 0), a2, voffA);
            PG8_BAR; PG8_WAIT_L(0); PG8_MMA(1, 0, At, B0); PG8_BAR; PG8_SCHED;
            PG8_STAGE(PG8_SB(0, 1), b2 + hstepB, voffB);
            PG8_WAIT_V(6); PG8_BAR; PG8_MMA(1, 1, At, B1); PG8_BAR;
            PG8_LDB(B0, 1, 0); PG8_SCHED; PG8_LDA(At, 1, 0); PG8_STAGE(PG8_SA(0, 1), a2 + hstepA, voffA);
            PG8_WAIT_L(8); PG8_BAR; PG8_WAIT_L(0); PG8_MMA(0, 0, At, B0); PG8_BAR; PG8_SCHED;
            PG8_LDB(B1, 1, 1); PG8_STAGE(PG8_SB(1, 0), b3, voffB);
            PG8_BAR; PG8_WAIT_L(0); PG8_MMA(0, 1, At, B1); PG8_BAR;
            PG8_LDA(At, 1, 1); PG8_STAGE(PG8_SA(1, 0), a3, voffA);
            PG8_BAR; PG8_WAIT_L(0); PG8_MMA(1, 0, At, B0); PG8_BAR; PG8_SCHED;
            PG8_STAGE(PG8_SB(1, 1), b3 + hstepB, voffB);
            PG8_WAIT_V(6); PG8_BAR; PG8_MMA(1, 1, At, B1); PG8_BAR;
        }
        E(acc, cur, wr, wc, fr, fq);
        if (!has_next) break;
#pragma unroll
        for (int a = 0; a < 2; ++a)
#pragma unroll
            for (int b = 0; b < 2; ++b)
#pragma unroll
                for (int m = 0; m < 4; ++m)
#pragma unroll
                    for (int n = 0; n < 2; ++n) acc[a][b][m][n] = (f32x4){0.f, 0.f, 0.f, 0.f};
        cur = nxt; cA = nA; cB = nB; ++ui;
    }
    PG8_WAIT_V(0);
    if (wr == 0) PG8_BAR;
    PG8_BAR;
#undef PG8_SA
#undef PG8_SB
#undef PG8_STAGE
#undef PG8_LDA
#undef PG8_LDB
#undef PG8_MMA
#undef PG8_WAIT_V
#undef PG8_WAIT_L
#undef PG8_BAR
#undef PG8_SCHED
}

template <class F> DI void epi_rows(const f32x4 (&acc)[2][2][4][2], const Unit& u, int wr, int wc, int fr, int fq, const F& f) {
    const int row0 = u.pm * BM + wr * 64 + fr, col0 = u.pn * BM + wc * 32 + 8 * fq;
#pragma unroll
    for (int ai = 0; ai < 2; ++ai)
#pragma unroll
        for (int m = 0; m < 4; ++m)
#pragma unroll
            for (int bj = 0; bj < 2; ++bj) f(row0 + ai * HALF + m * 16, col0 + bj * HALF, acc[ai][bj][m][0], acc[ai][bj][m][1]);
}
DI u32x4 pack_v(const f32x4 a, const f32x4 b) { u32x4 w; w.x = pk(a[0], a[1]); w.y = pk(a[2], a[3]); w.z = pk(b[0], b[1]); w.w = pk(b[2], b[3]); return w; }

struct EpiInproj { u16* u; float* dtraw; float* glr;
    DI void operator()(const f32x4 (&acc)[2][2][4][2], const Unit& un, int wr, int wc, int fr_, int fq_) const {
        const int fr = opaque(fr_), fq = opaque(fq_);
        epi_rows(acc, un, wr, wc, fr, fq, [&](int row, int col, f32x4 a, f32x4 b) {
            if (col >= U_ZA) {
#pragma unroll
                for (int j = 0; j < 4; ++j) { a[j] = siluf(a[j]); b[j] = siluf(b[j]); } }
            if (col >= U_DT && col < U_DT + 32) { float* d = dtraw + (size_t)row * 32 + (col - U_DT); *(f32x4*)d = a; *(f32x4*)(d + 4) = b; }
            if (col >= U_GLR && col < U_GLR + 32) { float* d = glr + (size_t)row * 32 + (col - U_GLR); *(f32x4*)d = a; *(f32x4*)(d + 4) = b; }
            *(u32x4*)(u + (size_t)row * UW + col) = pack_v(a, b);
        });
    } };
struct EpiQ { u16* q; const LAS float* rs;
    DI void operator()(const f32x4 (&acc)[2][2][4][2], const Unit& un, int wr, int wc, int fr, int fq) const {
        epi_rows(acc, un, wr, wc, fr, fq, [&](int row, int col, f32x4 a, f32x4 b) {
            const float s = rs[row - un.pm * BM];
            *(u32x4*)(q + (size_t)row * 768 + col) = pack_v(a * s, b * s);
        });
    } };
struct EpiKV { u16* km; u16* vm; const LAS float* rs;
    DI void operator()(const f32x4 (&acc)[2][2][4][2], const Unit& un, int wr, int wc, int fr, int fq) const {
        epi_rows(acc, un, wr, wc, fr, fq, [&](int row, int col, f32x4 a, f32x4 b) {
            const float s = rs[row - un.pm * BM];
            const int head = col >> 7, c = col & 127;
            u16* d = (c < 64) ? (km + (size_t)row * 768 + head * 96 + c) : (vm + (size_t)row * 512 + head * 64 + (c - 64));
            *(u32x4*)d = pack_v(a * s, b * s);
        });
    } };
struct EpiGate { u16* sg;
    DI void operator()(const f32x4 (&acc)[2][2][4][2], const Unit& un, int wr, int wc, int fr, int fq) const {
        epi_rows(acc, un, wr, wc, fr, fq, [&](int row, int col, f32x4 a, f32x4 b) {
#pragma unroll
            for (int j = 0; j < 4; ++j) { a[j] = sigmf(a[j]); b[j] = sigmf(b[j]); }
            *(u32x4*)(sg + (row - un.pm * BM) * 256 + (col - un.pn * BM)) = pack_v(a, b);
        });
    } };
struct EpiBranch { const u16* sg; float* sacc; u16* mixed; int first, last;
    DI void operator()(const f32x4 (&acc)[2][2][4][2], const Unit& un, int wr, int wc, int fr, int fq) const {
        const int lr0 = wr * 64 + fr, lc0 = wc * 32 + 8 * fq;
#pragma unroll
        for (int ai = 0; ai < 2; ++ai) {
            u32x4 gw[4][2], mw[4][2];
#pragma unroll
            for (int m = 0; m < 4; ++m)
#pragma unroll
                for (int bj = 0; bj < 2; ++bj) { const int lr = lr0 + ai * HALF + m * 16, lc = lc0 + bj * HALF;
                    gw[m][bj] = *(const u32x4*)(sg + lr * 256 + lc);
                    mw[m][bj] = first ? (u32x4){0u, 0u, 0u, 0u} : *(const u32x4*)(mixed + (size_t)(un.pm * BM + lr) * 1024 + un.pn * BM + lc); }
#pragma unroll
            for (int m = 0; m < 4; ++m)
#pragma unroll
                for (int bj = 0; bj < 2; ++bj) { const int lr = lr0 + ai * HALF + m * 16, lc = lc0 + bj * HALF;
                    const u32x4 g = gw[m][bj], w = mw[m][bj];
                    f32x4 a = acc[ai][bj][m][0] * (f32x4){bflo(g.x), bfhi(g.x), bflo(g.y), bfhi(g.y)} + (f32x4){bflo(w.x), bfhi(w.x), bflo(w.y), bfhi(w.y)};
                    f32x4 bb = acc[ai][bj][m][1] * (f32x4){bflo(g.z), bfhi(g.z), bflo(g.w), bfhi(g.w)} + (f32x4){bflo(w.z), bfhi(w.z), bflo(w.w), bfhi(w.w)};
                    *(u32x4*)(mixed + (size_t)(un.pm * BM + lr) * 1024 + un.pn * BM + lc) = pack_v(a, bb); }
        }
    } };
struct EpiP5 { u16* sg; float* sacc; u16* mixed;
    DI void operator()(const f32x4 (&acc)[2][2][4][2], const Unit& un, int wr, int wc, int fr_, int fq_) const {
        const int fr = opaque(fr_), fq = opaque(fq_);
        if (un.tag & 1) { EpiBranch e{sg, sacc, mixed, (un.tag >> 1) == 0, (un.tag >> 1) == 3}; e(acc, un, wr, wc, fr, fq); }
        else { EpiGate e{sg}; e(acc, un, wr, wc, fr, fq); }
    } };
struct P5Sched { const char* ws; int first, stride; int lda, ldb;
    DI bool next(int i, Unit& u) const { const int tile = i >> 3, pass = i & 7, br = pass >> 1; const int L = first + tile * stride; if (L >= 512) return false; tile_map(L, 128, 4, u);
        if (pass & 1) { u.A = (const u16*)(ws + (br == 0 ? OFF_AA : br == 1 ? OFF_AB : br == 2 ? OFF_AC : OFF_AD)); u.Bt = (const u16*)(ws + (br == 0 ? OFF_WA : br == 1 ? OFF_WB : br == 2 ? OFF_WC : OFF_WD));
            u.nt = (br == 0 ? 1024 : 512) / BK; }
        else { u.A = (const u16*)(ws + OFF_HB); u.Bt = (const u16*)(ws + OFF_WALL) + (size_t)br * 1024 * 1024; u.nt = 16; }
        u.tag = pass; return true; } };
struct EpiOut { const float* xin; float* out;
    DI void operator()(const f32x4 (&acc)[2][2][4][2], const Unit& un, int wr, int wc, int fr_, int fq_) const {
        const int fr = opaque(fr_), fq = opaque(fq_);
        const int row0 = un.pm * BM + wr * 64 + fr, col0 = un.pn * BM + wc * 32 + 8 * fq;
#pragma unroll
        for (int ai = 0; ai < 2; ++ai) {
            f32x4 x0[4][2], x1[4][2];
#pragma unroll
            for (int m = 0; m < 4; ++m)
#pragma unroll
                for (int bj = 0; bj < 2; ++bj) { const size_t o = (size_t)(row0 + ai * HALF + m * 16) * 1024 + col0 + bj * HALF; x0[m][bj] = *(const f32x4*)(xin + o); x1[m][bj] = *(const f32x4*)(xin + o + 4); }
#pragma unroll
            for (int m = 0; m < 4; ++m)
#pragma unroll
                for (int bj = 0; bj < 2; ++bj) { const size_t o = (size_t)(row0 + ai * HALF + m * 16) * 1024 + col0 + bj * HALF;
                    *(f32x4*)(out + o) = x0[m][bj] + acc[ai][bj][m][0]; *(f32x4*)(out + o + 4) = x1[m][bj] + acc[ai][bj][m][1]; }
        }
    } };
}

template <bool REMAP> DI void wtile(char* shm, const float* src, int ld, int K, int N, u16* dst, int dpitch, const float* scale, int tile) {
    const int tid = opaque(threadIdx.x), lane = tid & 63, wave = __builtin_amdgcn_readfirstlane(tid >> 6);
    float* tl = (float*)(shm + wave * 16640);
    const int nkt = K / 64, kt = tile % nkt, ntile = tile / nkt, k0 = kt * 64, n0 = ntile * 64;
    { const int n = n0 + lane; const bool ok = n < N; const float* sp = src + (size_t)k0 * ld + (ok ? n : 0);
      float v[64];
#pragma unroll
      for (int k = 0; k < 64; ++k) v[k] = sp[(size_t)k * ld];
#pragma unroll
      for (int k = 0; k < 64; ++k) { float x = ok ? v[k] : 0.f; if (scale) x *= scale[k0 + k]; tl[k * 65 + lane] = x; } }
    __builtin_amdgcn_wave_barrier();
    { const int kp = lane & 31, ns = lane >> 5;
#pragma unroll 8
      for (int i = 0; i < 32; ++i) { const int nl = 2 * i + ns, n = n0 + nl; if (n < N) { const int drow = REMAP ? (n < 4096 ? n : 4096 + ucol_of(n - 4096)) : n;
          *(unsigned*)(dst + (size_t)drow * dpitch + k0 + 2 * kp) = pk(tl[(2 * kp) * 65 + nl], tl[(2 * kp + 1) * 65 + nl]); } } }
    __builtin_amdgcn_wave_barrier();
}
DI void phase_weights(char* shm, const Params& p, int layer) {
    char* ws = p.ws;
    if (blockIdx.x == 0) { u32x4* z = (u32x4*)((u16*)(ws + OFF_WALL) + (size_t)(4096 + U_PAD) * 1024); for (int i = opaque(threadIdx.x); i < 32 * 1024 * 2 / 16; i += 512) z[i] = (u32x4){0u, 0u, 0u, 0u}; }
    const int c0 = 16 * 168, c1 = c0 + 6 * 12, c2 = c1 + 4 * 16, c3 = c2 + 256, c4 = c3 + 128, c5 = c4 + 128, c6 = c5 + 128, c7 = c6 + 256;
    const int gw_ = blockIdx.x * 8 + __builtin_amdgcn_readfirstlane(opaque(threadIdx.x) >> 6);
    for (int t = gw_; t < c7; t += gridDim.x * 8) {
        if (t < c0) wtile<true>(shm, p.in[2] + (size_t)layer * 1024 * NIN, NIN, 1024, NIN, (u16*)(ws + OFF_WALL), 1024, nullptr, t);
        else if (t < c1) wtile<false>(shm, p.in[11] + (size_t)layer * 384 * 768, 768, 384, 768, (u16*)(ws + OFF_WQ), 384, p.in[9] + layer * 384, t - c0);
        else if (t < c2) wtile<false>(shm, p.in[12] + (size_t)layer * 256 * 1024, 1024, 256, 1024, (u16*)(ws + OFF_WKV), 256, p.in[10] + layer * 256, t - c1);
        else if (t < c3) wtile<false>(shm, p.in[18] + (size_t)layer * 1024 * 1024, 1024, 1024, 1024, (u16*)(ws + OFF_WA), 1024, nullptr, t - c2);
        else if (t < c4) wtile<false>(shm, p.in[19] + (size_t)layer * 512 * 1024, 1024, 512, 1024, (u16*)(ws + OFF_WB), 1024, nullptr, t - c3);
        else if (t < c5) wtile<false>(shm, p.in[20] + (size_t)layer * 512 * 1024, 1024, 512, 1024, (u16*)(ws + OFF_WC), 1024, nullptr, t - c4);
        else if (t < c6) wtile<false>(shm, p.in[21] + (size_t)layer * 512 * 1024, 1024, 512, 1024, (u16*)(ws + OFF_WD), 1024, nullptr, t - c5);
        else wtile<false>(shm, p.in[22] + (size_t)layer * 1024 * 1024, 1024, 1024, 1024, (u16*)(ws + OFF_WO), 1024, nullptr, t - c6);
    }
}

DI float wave_sum(float v) {
#pragma unroll
    for (int o = 32; o >= 1; o >>= 1) v += __shfl_xor(v, o);
    return v;
}
template <bool FINAL> DI void phase_rownorm(const float* xin, const float* g, u16* hb, float* fout) {
    const int tidx = opaque(threadIdx.x); const int lane = tidx & 63, gw = blockIdx.x * 8 + (tidx >> 6), nw = gridDim.x * 8;
    f32x4 gg[4];
#pragma unroll
    for (int i = 0; i < 4; ++i) gg[i] = ((const f32x4*)g)[lane + 64 * i];
    for (int row = gw; row < T_ALL; row += 2 * nw) {
        const int row1 = row + nw; const bool has1 = row1 < T_ALL;
        const f32x4* xr0 = (const f32x4*)(xin + (size_t)row * 1024); const f32x4* xr1 = (const f32x4*)(xin + (size_t)(has1 ? row1 : row) * 1024);
        f32x4 v0[4], v1[4]; float s0 = 0.f, s1 = 0.f;
#pragma unroll
        for (int i = 0; i < 4; ++i) { v0[i] = xr0[lane + 64 * i]; v1[i] = xr1[lane + 64 * i]; }
#pragma unroll
        for (int i = 0; i < 4; ++i) { s0 += v0[i][0] * v0[i][0] + v0[i][1] * v0[i][1] + v0[i][2] * v0[i][2] + v0[i][3] * v0[i][3]; s1 += v1[i][0] * v1[i][0] + v1[i][1] * v1[i][1] + v1[i][2] * v1[i][2] + v1[i][3] * v1[i][3]; }
        s0 = wave_sum(s0); s1 = wave_sum(s1);
        const float r0 = rsqrtf(s0 * (1.f / 1024.f) + EPS), r1 = rsqrtf(s1 * (1.f / 1024.f) + EPS);
#pragma unroll
        for (int i = 0; i < 4; ++i) { const f32x4 o0 = v0[i] * r0 * gg[i], o1 = v1[i] * r1 * gg[i];
            if (FINAL) { ((f32x4*)(fout + (size_t)row * 1024))[lane + 64 * i] = o0; if (has1) ((f32x4*)(fout + (size_t)row1 * 1024))[lane + 64 * i] = o1; }
            else { u32x2 w; w.x = pk(o0[0], o0[1]); w.y = pk(o0[2], o0[3]); *(u32x2*)(hb + (size_t)row * 1024 + 4 * (lane + 64 * i)) = w;
                   if (has1) { w.x = pk(o1[0], o1[1]); w.y = pk(o1[2], o1[3]); *(u32x2*)(hb + (size_t)row1 * 1024 + 4 * (lane + 64 * i)) = w; } } }
    }
}

template <int K> DI void rowstat(char* shm, const u16* A, int lda, int row0) {
    const int tid = opaque(threadIdx.x), r = tid >> 1, half = tid & 1; constexpr int N16 = K / 16;
    const u32x4* src = (const u32x4*)(A + (size_t)(row0 + r) * lda + half * (K / 2));
    u32x4 v[N16];
#pragma unroll
    for (int i = 0; i < N16; ++i) v[i] = src[i];
    float ss = 0.f;
#pragma unroll
    for (int i = 0; i < N16; ++i) { float f[8]; unpack8(v[i], f);
#pragma unroll
        for (int j = 0; j < 8; ++j) ss += f[j] * f[j]; }
    ss += __shfl_xor(ss, 1);
    if (half == 0) ((float*)(shm + STAGE_BYTES))[r] = rsqrtf(ss / (float)K + EPS);
    __syncthreads();
}
DI void conv_task(const Params& p, int layer, char* grp, int task, int lane_in) {
    const int lane = opaque(lane_in);
    const int run = task / 3, chunk = task - run * 3, c = chunk * 512 + lane * 8, t0 = run * 16, pos0 = t0 & (SEQ - 1);
    const u16* u = (const u16*)(grp + G_U); u16* xc = (u16*)(grp + G_XC);
    const float* cw = p.in[3] + (size_t)layer * 5 * 1536 + c; const float* cb = p.in[4] + (size_t)layer * 1536 + c;
    u32x4 rows[20];
#pragma unroll
    for (int i = 0; i < 20; ++i) { const int pp = pos0 - 2 + i; rows[i] = (u32x4){0u, 0u, 0u, 0u};
        if (pp >= 0 && pp < SEQ) rows[i] = __builtin_nontemporal_load((const u32x4*)(u + (size_t)(t0 - 2 + i) * UW + U_XBC + c)); }
    float w[5][8], bias[8];
#pragma unroll
    for (int j = 0; j < 5; ++j) { const f32x4 w0 = *(const f32x4*)(cw + j * 1536), w1 = *(const f32x4*)(cw + j * 1536 + 4);
        w[j][0] = w0[0]; w[j][1] = w0[1]; w[j][2] = w0[2]; w[j][3] = w0[3]; w[j][4] = w1[0]; w[j][5] = w1[1]; w[j][6] = w1[2]; w[j][7] = w1[3]; }
    { const f32x4 b0 = *(const f32x4*)cb, b1 = *(const f32x4*)(cb + 4); bias[0] = b0[0]; bias[1] = b0[1]; bias[2] = b0[2]; bias[3] = b0[3]; bias[4] = b1[0]; bias[5] = b1[1]; bias[6] = b1[2]; bias[7] = b1[3]; }
#pragma unroll
    for (int o = 0; o < 16; ++o) { float acc[8];
#pragma unroll
        for (int e = 0; e < 8; ++e) acc[e] = bias[e];
#pragma unroll
        for (int j = 0; j < 5; ++j) { float f[8]; unpack8(rows[o + j], f);
#pragma unroll
            for (int e = 0; e < 8; ++e) acc[e] += f[e] * w[j][e]; }
#pragma unroll
        for (int e = 0; e < 8; ++e) acc[e] = siluf(acc[e]);
        *(u32x4*)(xc + (size_t)(t0 + o) * 1536 + c) = pack8(acc); }
}
template <int NT> DI void prep_tokens(const Params& p, int layer, char* grp, int tg0, int tstride, int lane_in) {
    const int lane = opaque(lane_in);
    const u16* u = (const u16*)(grp + G_U);
    const int cq = lane, ck = lane & 15, cr = lane & 31;
    u32x4 qraw[NT], kraw[NT]; float xr[NT], dr[NT];
#pragma unroll
    for (int k = 0; k < NT; ++k) { const size_t tg = (size_t)(tg0 + k * tstride);
        qraw[k] = *(const u32x4*)(u + tg * UW + U_QD + cq * 8); kraw[k] = *(const u32x4*)(u + tg * UW + U_KD + ck * 8);
        xr[k] = bf2f(u[tg * UW + U_KROPE + cr]); dr[k] = ((const float*)(grp + G_DTRAW))[tg * 32 + cr]; }
    const float dtb = p.in[6][layer * 32 + cr];
#pragma unroll
    for (int k = 0; k < NT; ++k) { const int tg = tg0 + k * tstride; const int pos = tg & (SEQ - 1);
        const float prow = (float)(pos >> 6), pcol = (float)(pos & 63);
        if (lane < 32) ((float*)(grp + G_DTV))[(size_t)tg * 32 + lane] = softplusf(dr[k] + dtb);
#pragma unroll
        for (int which = 0; which < 2; ++which) {
            const int j = lane & 7;
            const float* gn = (which ? p.in[17] : p.in[16]) + layer * 64;
            float f[8]; unpack8(which ? kraw[k] : qraw[k], f);
            float ss = 0.f;
#pragma unroll
            for (int e = 0; e < 8; ++e) ss += f[e] * f[e];
            ss += __shfl_xor(ss, 1); ss += __shfl_xor(ss, 2); ss += __shfl_xor(ss, 4);
            const float rstd = rsqrtf(ss * (1.f / 64.f) + EPS);
            float o[8];
#pragma unroll
            for (int e = 0; e < 8; ++e) f[e] = f[e] * rstd * gn[8 * j + e];
#pragma unroll
            for (int e = 0; e < 8; ++e) { const float pr = __shfl_xor(f[e], 2); const int col = 8 * j + e, i = col & 31, fi = i & 15;
                const float inv = fexp2(-(float)fi * (13.287712379549449f / 16.f)); float c, s_; sincos_rope(((col >> 5) ? pcol : prow) * inv, c, s_);
                o[e] = f[e] * c + ((i < 16) ? -pr : pr) * s_; }
            if (which == 0) *(u32x4*)((u16*)(grp + G_QG) + (size_t)tg * 512 + lane * 8) = pack8(o);
            else if (lane < 16) *(u32x4*)((u16*)(grp + G_KG) + (size_t)tg * 128 + lane * 8) = pack8(o);
        }
        { const int i = cr; const float x = xr[k]; const float pr = __shfl_xor(x, 8); const int ii = i & 15, fi = ii & 7;
          const float inv = fexp2(-(float)fi * (13.287712379549449f / 8.f)); float c, s_; sincos_rope(((i >> 4) ? pcol : prow) * inv, c, s_);
          const u16 o = f2bf(x * c + ((ii < 8) ? -pr : pr) * s_);
          if (lane < 32) { u16* km = (u16*)(grp + G_KM) + (size_t)tg * 768 + 64 + i;
#pragma unroll
              for (int hh = 0; hh < 8; ++hh) km[hh * 96] = o; } }
    }
}

template <int D, bool MLA>
DI void attn_item(char* shm, const u16* Q, int qpitch, const u16* Kp, int kpitch, const u16* V, int vpitch, const u16* Z, int zpitch, u16* O, int opitch, int tok0, int q0, float scale) {
    constexpr int KCH = D / 8, KP = D * 2 + 16, VP = 144, KBYTES = 64 * KP, VBYTES = 64 * VP, BUF = KBYTES + VBYTES, NKK = D / 16;
    const int tid = opaque(threadIdx.x), lane = tid & 63, wave = __builtin_amdgcn_readfirstlane(tid >> 6), r = lane & 31, h = lane >> 5;
    const int qpos = q0 + wave * 32 + r; const size_t qrow = (size_t)(tok0 + qpos);
    bf16x8 qf[NKK];
    { const float sc = scale * LOG2E;
#pragma unroll
      for (int kk = 0; kk < NKK; ++kk) { float f[8]; unpack8(*(const u32x4*)(Q + qrow * qpitch + 16 * kk + 8 * h), f);
          if (MLA && kk >= 4) { const float pv = (kk == 4) ? (float)(qpos >> 6) : (float)(qpos & 63);
#pragma unroll
              for (int j = 0; j < 8; ++j) { const float pr = __shfl_xor(f[j], 32); const float inv = fexp2(-(float)j * (13.287712379549449f / 8.f)); float c, s; sincos_rope(pv * inv, c, s);
                  f[j] = f[j] * c + (h ? pr : -pr) * s; } }
#pragma unroll
          for (int j = 0; j < 8; ++j) f[j] *= sc;
          qf[kk] = __builtin_bit_cast(bf16x8, pack8(f)); } }
    constexpr int TK = 128, KB2 = TK * KP, VB2 = TK * VP, BUF2 = KB2 + VB2, NKC = (KCH * TK + 511) / 512, NT = SEQ / TK;
    struct AttRegs { u32x4 k[NKC]; u32x4 v[2]; };
    AttRegs RA, RB;
#define ATT_GLOAD(kt, R) do { _Pragma("unroll") for (int c_ = 0; c_ < NKC; ++c_) { const int id_ = tid + 512 * c_; if (id_ < KCH * TK) R.k[c_] = *(const u32x4*)(Kp + (size_t)(tok0 + TK * (kt) + id_ / KCH) * kpitch + (id_ % KCH) * 8); } \
        _Pragma("unroll") for (int c_ = 0; c_ < 2; ++c_) { const int id_ = tid + 512 * c_; R.v[c_] = *(const u32x4*)(V + (size_t)(tok0 + TK * (kt) + (id_ >> 3)) * vpitch + (id_ & 7) * 8); } } while (0)
#define ATT_LSTORE(buf, R) do { char* b_ = shm + (buf) * BUF2; \
        _Pragma("unroll") for (int c_ = 0; c_ < NKC; ++c_) { const int id_ = tid + 512 * c_; if (id_ < KCH * TK) *(LAS u32x4*)(b_ + (id_ / KCH) * KP + (id_ % KCH) * 16) = R.k[c_]; } \
        _Pragma("unroll") for (int c_ = 0; c_ < 2; ++c_) { const int id_ = tid + 512 * c_; *(LAS u32x4*)(b_ + KB2 + (id_ >> 3) * VP + (id_ & 7) * 16) = R.v[c_]; } } while (0)
    f32x16 o0 = zero16(), o1 = zero16(); float mrun = 0.f, lsum = 0.f;
    const int i16 = lane & 15, tq = i16 >> 2, tp = i16 & 3, blk = (lane >> 4) & 1;
    __syncthreads();
    ATT_GLOAD(0, RA); ATT_LSTORE(0, RA); ATT_GLOAD(1, RB);
    __syncthreads();
#define ATT_BODY(kt, RL, RS) do { \
        if ((kt) + 2 < NT) ATT_GLOAD((kt) + 2, RL); \
        const char* kb_ = shm + ((kt) & 1) * BUF2; const char* vb_ = kb_ + KB2; \
        f32x16 sc[4]; \
        { const float nm = -mrun; \
          _Pragma("unroll") for (int q = 0; q < 4; ++q) _Pragma("unroll") for (int i = 0; i < 16; ++i) sc[q][i] = nm; } \
        _Pragma("unroll") for (int kk = 0; kk < NKK; ++kk) _Pragma("unroll") for (int q = 0; q < 4; ++q) sc[q] = MFMA32(lds_frag(kb_ + (32 * q + r) * KP + (16 * kk + 8 * h) * 2), qf[kk], sc[q]); \
        _Pragma("unroll") for (int hf = 0; hf < 2; ++hf) {     \
            float mx = sc[2 * hf][0]; \
            _Pragma("unroll") for (int q = 0; q < 2; ++q) _Pragma("unroll") for (int i = 0; i < 16; ++i) mx = fmaxf(mx, sc[2 * hf + q][i]); \
            mx = fmaxf(mx, __shfl_xor(mx, 32)); \
            const bool need = ((kt) == 0 && hf == 0) || (mx > 8.f); \
            if (__builtin_amdgcn_ballot_w64(need) != 0ull) { \
                const float delta = need ? mx : 0.f, alpha = fexp2(fmaxf(-delta, -126.f)); \
                mrun += delta; lsum *= alpha; \
                _Pragma("unroll") for (int i = 0; i < 16; ++i) { o0[i] *= alpha; o1[i] *= alpha; } \
                _Pragma("unroll") for (int q = 2 * hf; q < 4; ++q) _Pragma("unroll") for (int i = 0; i < 16; ++i) sc[q][i] -= delta; \
            } \
            float ps = 0.f; \
            _Pragma("unroll") for (int q = 0; q < 2; ++q) _Pragma("unroll") for (int i = 0; i < 16; ++i) { sc[2 * hf + q][i] = fexp2(sc[2 * hf + q][i]); ps += sc[2 * hf + q][i]; } \
            lsum += ps; \
            _Pragma("unroll") for (int kq = 0; kq < 2; ++kq) _Pragma("unroll") for (int sp = 0; sp < 2; ++sp) { const int kb = 2 * hf + kq; \
                u32x4 pw; \
                pw.x = pk(sc[kb][8 * sp], sc[kb][8 * sp + 1]); pw.y = pk(sc[kb][8 * sp + 2], sc[kb][8 * sp + 3]); pw.z = pk(sc[kb][8 * sp + 4], sc[kb][8 * sp + 5]); pw.w = pk(sc[kb][8 * sp + 6], sc[kb][8 * sp + 7]); \
                const bf16x8 pf = __builtin_bit_cast(bf16x8, pw); \
                const char* va = vb_ + (32 * kb + 16 * sp + 4 * h + tq) * VP + (16 * blk + 4 * tp) * 2; \
                { const s16x4 lo = __builtin_amdgcn_ds_read_tr16_b64_v4i16((LAS s16x4*)va), hi = __builtin_amdgcn_ds_read_tr16_b64_v4i16((LAS s16x4*)(va + 8 * VP)); \
                  o0 = MFMA32(__builtin_shufflevector(lo, hi, 0, 1, 2, 3, 4, 5, 6, 7), pf, o0); } \
                { const s16x4 lo = __builtin_amdgcn_ds_read_tr16_b64_v4i16((LAS s16x4*)(va + 64)), hi = __builtin_amdgcn_ds_read_tr16_b64_v4i16((LAS s16x4*)(va + 64 + 8 * VP)); \
                  o1 = MFMA32(__builtin_shufflevector(lo, hi, 0, 1, 2, 3, 4, 5, 6, 7), pf, o1); } \
            } \
        } \
        if ((kt) + 1 < NT) ATT_LSTORE(((kt) + 1) & 1, RS); \
        __syncthreads(); } while (0)
#pragma unroll 1
    for (int kt = 0; kt < NT; kt += 2) { ATT_BODY(kt, RA, RB); ATT_BODY(kt + 1, RB, RA); }
#undef ATT_BODY
#undef ATT_GLOAD
#undef ATT_LSTORE
    lsum += __shfl_xor(lsum, 32);
    const float inv = 1.f / lsum;
#pragma unroll
    for (int dvt = 0; dvt < 2; ++dvt)
#pragma unroll
        for (int g4 = 0; g4 < 4; ++g4) { const int dv = 32 * dvt + 8 * g4 + 4 * h;
            const u32x2 zw = *(const u32x2*)(Z + qrow * zpitch + dv);
            float v0, v1, v2, v3;
            if (dvt == 0) { v0 = o0[4 * g4]; v1 = o0[4 * g4 + 1]; v2 = o0[4 * g4 + 2]; v3 = o0[4 * g4 + 3]; } else { v0 = o1[4 * g4]; v1 = o1[4 * g4 + 1]; v2 = o1[4 * g4 + 2]; v3 = o1[4 * g4 + 3]; }
            u32x2 w; w.x = pk(v0 * inv * bflo(zw.x), v1 * inv * bfhi(zw.x)); w.y = pk(v2 * inv * bflo(zw.y), v3 * inv * bfhi(zw.y));
            *(u32x2*)(O + qrow * opitch + dv) = w; }
}

DI void ssd_item(char* shm, const Params& p, int layer, char* grp, int item) {
    const int b = item >> 5, hd = (item >> 1) & 15, dir = item & 1, grpi = hd >> 3, tokbase = b * SEQ;
    const int tid = opaque(threadIdx.x), lane = tid & 63, wave = __builtin_amdgcn_readfirstlane(tid >> 6), r = lane & 31, h = lane >> 5;
    char* cm_ = shm; char* bm_ = shm + 17408; char* xd_ = shm + 34816; char* xdd_ = shm + 44032; char* mm_ = shm + 53248; char* sb_ = shm + 62464;
    float* acum = (float*)(shm + 79872); float* dts = acum + 128; float* eacs = acum + 256;
    const u16* xc = (const u16*)(grp + G_XC); const float* dtv = (const float*)(grp + G_DTV);
    u16* yout = (u16*)(grp + (dir ? G_YB : G_YF));
    const float a_neg = -__expf(p.in[5][layer * 32 + dir * 16 + hd]);
    const int lrow0 = tid >> 4, lch = tid & 15, xrow = tid >> 3, xch = tid & 7;
    struct SsdRegs { u32x4 cm0, cm1, bm0, bm1, xs; float dt; };
    SsdRegs RA, RB; RA.dt = 0.f; RB.dt = 0.f;
#define SSD_TOK(tau) ((size_t)(tokbase + (dir ? SEQ - 1 - (tau) : (tau))))
#define SSD_LOADG(c, R) do { const size_t t0_ = SSD_TOK(64 * (c) + lrow0), t1_ = SSD_TOK(64 * (c) + lrow0 + 32); \
        R.cm0 = *(const u32x4*)(xc + t0_ * 1536 + 1280 + 128 * grpi + lch * 8); R.cm1 = *(const u32x4*)(xc + t1_ * 1536 + 1280 + 128 * grpi + lch * 8); \
        R.bm0 = *(const u32x4*)(xc + t0_ * 1536 + 1024 + 128 * grpi + lch * 8); R.bm1 = *(const u32x4*)(xc + t1_ * 1536 + 1024 + 128 * grpi + lch * 8); \
        R.xs = *(const u32x4*)(xc + SSD_TOK(64 * (c) + xrow) * 1536 + hd * 64 + xch * 8); \
        if (tid < 64) R.dt = dtv[SSD_TOK(64 * (c) + tid) * 32 + dir * 16 + hd]; } while (0)
#define SSD_SCAN(buf, R) do { if (tid < 64) { float v_ = R.dt * a_neg; \
        _Pragma("unroll") for (int o_ = 1; o_ < 64; o_ <<= 1) { const float n_ = __shfl_up(v_, o_); if (lane >= o_) v_ += n_; } \
        dts[(buf) * 64 + tid] = R.dt; acum[(buf) * 64 + tid] = v_; eacs[(buf) * 64 + tid] = fexp(v_); } } while (0)
    __syncthreads();
    for (int i = tid; i < 17408 / 16; i += 512) *(LAS u32x4*)(sb_ + i * 16) = (u32x4){0u, 0u, 0u, 0u};
    SSD_LOADG(0, RA); SSD_LOADG(1, RB); SSD_SCAN(0, RA);
    __syncthreads();
    f32x16 sacc = zero16();
#define SSD_BODY(c, R, RN) do { \
        const float* ac = acum + ((c) & 1) * 64; const float* dcur = dts + ((c) & 1) * 64; const float* eac = eacs + ((c) & 1) * 64; \
        *(LAS u32x4*)(cm_ + lrow0 * 272 + lch * 16) = R.cm0; *(LAS u32x4*)(cm_ + (lrow0 + 32) * 272 + lch * 16) = R.cm1; \
        *(LAS u32x4*)(bm_ + lrow0 * 272 + lch * 16) = R.bm0; *(LAS u32x4*)(bm_ + (lrow0 + 32) * 272 + lch * 16) = R.bm1; \
        { const float d = dcur[xrow], de = fexp(ac[63] - ac[xrow]); float f[8], g[8]; unpack8(R.xs, f); \
          _Pragma("unroll") for (int j = 0; j < 8; ++j) { f[j] *= d; g[j] = f[j] * de; } \
          *(LAS u32x4*)(xd_ + xrow * 144 + xch * 16) = pack8(f); *(LAS u32x4*)(xdd_ + xrow * 144 + xch * 16) = pack8(g); } \
        if ((c) + 2 < 32) SSD_LOADG((c) + 2, R); \
        __syncthreads(); \
        f32x16 y = zero16(); int lt = 0, pt = 0; \
        if (wave < 4) { \
            const int st = wave & 1, lt2 = wave >> 1; f32x16 cb = zero16(); \
            _Pragma("unroll") for (int kk = 0; kk < 8; ++kk) cb = MFMA32(lds_frag(bm_ + (32 * st + r) * 272 + (16 * kk + 8 * h) * 2), lds_frag(cm_ + (32 * lt2 + r) * 272 + (16 * kk + 8 * h) * 2), cb); \
            const int l = 32 * lt2 + r; const float al = ac[l]; \
            _Pragma("unroll") for (int g4 = 0; g4 < 4; ++g4) { const int s0 = 32 * st + 8 * g4 + 4 * h; float v[4]; const f32x4 as4 = *(const LAS f32x4*)(ac + s0); \
                _Pragma("unroll") for (int j = 0; j < 4; ++j) { const int s_ = s0 + j; v[j] = (s_ <= l) ? cb[4 * g4 + j] * fexp(al - as4[j]) : 0.f; } \
                u32x2 w; w.x = pk(v[0], v[1]); w.y = pk(v[2], v[3]); *(LAS u32x2*)(mm_ + l * 144 + s0 * 2) = w; } \
        } else { \
            lt = (wave - 4) >> 1; pt = (wave - 4) & 1; \
            _Pragma("unroll") for (int kk = 0; kk < 8; ++kk) y = MFMA32(lds_frag(cm_ + (32 * lt + r) * 272 + (16 * kk + 8 * h) * 2), lds_frag(sb_ + (32 * pt + r) * 272 + (16 * kk + 8 * h) * 2), y); \
            _Pragma("unroll") for (int g4 = 0; g4 < 4; ++g4) { const f32x4 e4 = *(const LAS f32x4*)(eac + 32 * lt + 8 * g4 + 4 * h); \
                _Pragma("unroll") for (int j = 0; j < 4; ++j) y[4 * g4 + j] *= e4[j]; } \
        } \
        __syncthreads(); \
        if ((c) + 1 < 32) SSD_SCAN(((c) + 1) & 1, RN); \
        if (wave >= 4) { \
            _Pragma("unroll") for (int kk = 0; kk < 4; ++kk) y = MFMA32(lds_frag(mm_ + (32 * lt + r) * 144 + (16 * kk + 8 * h) * 2), frag_tr(xd_, 144, 16 * kk, 32 * pt, lane), y); \
            { const unsigned voff = (unsigned)(((dir ? 4 - 4 * h : 4 * h) * 1024 + r) * 2); const int tb = dir ? (SEQ - 1 - 64 * (c) - 32 * lt - 4) : (64 * (c) + 32 * lt); \
              _Pragma("unroll") for (int i = 0; i < 16; ++i) { const int k_ = (i & 3) + 8 * (i >> 2); const int trow = dir ? tb - k_ : tb + k_; \
                char* ub = (char*)(yout + (size_t)(tokbase + trow) * 1024 + hd * 64 + 32 * pt); *(u16*)(ub + voff) = f2bf(y[i]); } } \
        } \
        { \
            const int nt = wave >> 1, pt2 = wave & 1; const float cd = fexp(ac[63]); \
            _Pragma("unroll") for (int i = 0; i < 16; ++i) sacc[i] *= cd; \
            _Pragma("unroll") for (int kk = 0; kk < 4; ++kk) sacc = MFMA32(frag_tr(bm_, 272, 16 * kk, 32 * nt, lane), frag_tr(xdd_, 144, 16 * kk, 32 * pt2, lane), sacc); \
            const int pp = 32 * pt2 + r; \
            _Pragma("unroll") for (int g4 = 0; g4 < 4; ++g4) { u32x2 w; w.x = pk(sacc[4 * g4], sacc[4 * g4 + 1]); w.y = pk(sacc[4 * g4 + 2], sacc[4 * g4 + 3]); \
                *(LAS u32x2*)(sb_ + pp * 272 + (32 * nt + 8 * g4 + 4 * h) * 2) = w; } \
        } \
        __syncthreads(); } while (0)
#pragma unroll 1
    for (int c = 0; c < 32; c += 2) { SSD_BODY(c, RA, RB); SSD_BODY(c + 1, RB, RA); }
#undef SSD_BODY
#undef SSD_TOK
#undef SSD_LOADG
#undef SSD_SCAN
}

DI u16* gla_img(char* ws, int which) { return (u16*)(ws + OFF_AD) + 512 + (size_t)which * TG * 1024; }
DI void gla_prep_task(char* shm, const Params& p, int layer, char* grp, int task) {
    const int b = task >> 8, c = (task >> 3) & 31, hd = (task >> 1) & 3, dir = task & 1, tokbase = b * SEQ;
    const int tid = opaque(threadIdx.x), kc = tid & 63, sg = tid >> 6, lrow0 = tid >> 4, lrr = tid & 15;
    float* gl_ = (float*)shm; float* seg_ = gl_ + 1024;
    const u16* u = (const u16*)(grp + G_U); const float* glr = (const float*)(grp + G_GLR);
#define GLA_TOK(tau) ((size_t)(tokbase + (dir ? SEQ - 1 - (tau) : (tau))))
    __syncthreads();
    gl_[tid] = glr[GLA_TOK(64 * c + lrow0) * 32 + dir * 16 + lrr]; gl_[tid + 512] = glr[GLA_TOK(64 * c + lrow0 + 32) * 32 + dir * 16 + lrr];
    float wreg[16]; float bgk;
    { const float* wg = p.in[13] + ((size_t)(layer * 2 + dir) * 16) * 256 + hd * 64;
#pragma unroll
      for (int rr = 0; rr < 16; ++rr) wreg[rr] = wg[rr * 256 + kc];
      bgk = p.in[14][(layer * 2 + dir) * 256 + hd * 64 + kc]; }
    u16 qv[8], kv[8];
#pragma unroll
    for (int i = 0; i < 8; ++i) { const size_t t = GLA_TOK(64 * c + 8 * sg + i); qv[i] = u[t * UW + U_QC + hd * 64 + kc]; kv[i] = u[t * UW + U_KC + hd * 64 + kc]; }
    __syncthreads();
    float gc[8]; float run = 0.f;
#pragma unroll
    for (int i = 0; i < 8; ++i) { const int l = 8 * sg + i; float pre = bgk;
#pragma unroll
        for (int q4 = 0; q4 < 4; ++q4) { const f32x4 gv = *(const LAS f32x4*)(gl_ + l * 16 + 4 * q4); pre += gv[0] * wreg[4 * q4] + gv[1] * wreg[4 * q4 + 1] + gv[2] * wreg[4 * q4 + 2] + gv[3] * wreg[4 * q4 + 3]; }
        const float lg = (fminf(pre, 0.f) - 0.6931471805599453f * __builtin_amdgcn_logf(1.f + fexp(-fabsf(pre)))) * (1.f / 16.f); run += lg; gc[i] = run; }
    seg_[sg * 64 + kc] = run;
    __syncthreads();
    float off = 0.f, tot = 0.f;
#pragma unroll
    for (int s2 = 0; s2 < 8; ++s2) { const float v = seg_[s2 * 64 + kc]; tot += v; if (s2 < sg) off += v; }
    u16* qg = gla_img(p.ws, 0); u16* kg = gla_img(p.ws, 1); u16* ke = gla_img(p.ws, 2);
#pragma unroll
    for (int i = 0; i < 8; ++i) { const float g = gc[i] + off; const float qf_ = bf2f(qv[i]), kf_ = bf2f(kv[i]);
        const size_t o = GLA_TOK(64 * c + 8 * sg + i) * 1024 + dir * 256 + hd * 64 + kc;
        qg[o] = f2bf(qf_ * 0.125f * fexp(g)); kg[o] = f2bf(kf_ * fexp(-g)); ke[o] = f2bf(kf_ * fexp(tot - g)); }
    if (sg == 0) ((float*)(p.ws + OFF_GDEC))[(size_t)task * 64 + kc] = fexp(tot);
#undef GLA_TOK
}
DI void gla_item(char* shm, const Params& p, int layer, char* grp, int item) {
    const int b = item >> 3, hd = (item >> 1) & 3, dir = item & 1, tokbase = b * SEQ;
    const int tid = opaque(threadIdx.x), lane = tid & 63, wave = __builtin_amdgcn_readfirstlane(tid >> 6), r = lane & 31, h = lane >> 5;
    char* qg_ = shm; char* kg_ = shm + 9216; char* ke_ = shm + 18432; char* v_ = shm + 27648; char* att_ = shm + 45056; char* sbt_ = shm + 54272;
    float* g63_ = (float*)(shm + 72704);
    const u16* u = (const u16*)(grp + G_U);
    const u16* qgi = gla_img(p.ws, 0) + dir * 256 + hd * 64; const u16* kgi = gla_img(p.ws, 1) + dir * 256 + hd * 64; const u16* kei = gla_img(p.ws, 2) + dir * 256 + hd * 64;
    const float* gdec = (const float*)(p.ws + OFF_GDEC);
    u16* oout = (u16*)(grp + (dir ? G_OB : G_OF));
    const int lrow0 = tid >> 4, lrr = tid & 15, xrow = tid >> 3, xch = tid & 7;
    struct GlaRegs { u32x4 v0, v1, qg, kg, ke; float dec; };
    GlaRegs RA, RB; RA.dec = 0.f; RB.dec = 0.f;
#define GLA_TOK(tau) ((size_t)(tokbase + (dir ? SEQ - 1 - (tau) : (tau))))
#define GLA_LOADG(c, R) do { const size_t t0_ = GLA_TOK(64 * (c) + lrow0), t1_ = GLA_TOK(64 * (c) + lrow0 + 32), tx_ = GLA_TOK(64 * (c) + xrow); \
        R.v0 = *(const u32x4*)(u + t0_ * UW + U_VC + hd * 128 + lrr * 8); R.v1 = *(const u32x4*)(u + t1_ * UW + U_VC + hd * 128 + lrr * 8); \
        R.qg = __builtin_nontemporal_load((const u32x4*)(qgi + tx_ * 1024 + xch * 8)); R.kg = __builtin_nontemporal_load((const u32x4*)(kgi + tx_ * 1024 + xch * 8)); R.ke = __builtin_nontemporal_load((const u32x4*)(kei + tx_ * 1024 + xch * 8)); \
        if (tid < 64) R.dec = gdec[(size_t)((((b * 32 + (c)) * 4 + hd) * 2) + dir) * 64 + tid]; } while (0)
    __syncthreads();
    for (int i = tid; i < 18432 / 16; i += 512) *(LAS u32x4*)(sbt_ + i * 16) = (u32x4){0u, 0u, 0u, 0u};
    GLA_LOADG(0, RA); GLA_LOADG(1, RB);
    f32x16 sacc = zero16();
#define GLA_BODY(c, R) do { \
        *(LAS u32x4*)(v_ + lrow0 * 272 + lrr * 16) = R.v0; *(LAS u32x4*)(v_ + (lrow0 + 32) * 272 + lrr * 16) = R.v1; \
        *(LAS u32x4*)(qg_ + xrow * 144 + xch * 16) = R.qg; *(LAS u32x4*)(kg_ + xrow * 144 + xch * 16) = R.kg; *(LAS u32x4*)(ke_ + xrow * 144 + xch * 16) = R.ke; \
        if (tid < 64) g63_[tid] = R.dec; \
        if ((c) + 2 < 32) GLA_LOADG((c) + 2, R); \
        __syncthreads(); \
        if (wave < 4) { \
            const int st = wave & 1, lt2 = wave >> 1; f32x16 at = zero16(); \
            _Pragma("unroll") for (int kk = 0; kk < 4; ++kk) at = MFMA32(lds_frag(kg_ + (32 * st + r) * 144 + (16 * kk + 8 * h) * 2), lds_frag(qg_ + (32 * lt2 + r) * 144 + (16 * kk + 8 * h) * 2), at); \
            const int l = 32 * lt2 + r; \
            _Pragma("unroll") for (int g4 = 0; g4 < 4; ++g4) { const int s0 = 32 * st + 8 * g4 + 4 * h; float v[4]; \
                _Pragma("unroll") for (int j = 0; j < 4; ++j) v[j] = (s0 + j <= l) ? at[4 * g4 + j] : 0.f; \
                u32x2 w; w.x = pk(v[0], v[1]); w.y = pk(v[2], v[3]); *(LAS u32x2*)(att_ + l * 144 + s0 * 2) = w; } \
        } \
        const int lt = wave >> 2, vt = wave & 3; \
        f32x16 o = zero16(); \
        _Pragma("unroll") for (int kk = 0; kk < 4; ++kk) o = MFMA32(lds_frag(qg_ + (32 * lt + r) * 144 + (16 * kk + 8 * h) * 2), lds_frag(sbt_ + (32 * vt + r) * 144 + (16 * kk + 8 * h) * 2), o); \
        __syncthreads(); \
        _Pragma("unroll") for (int kk = 0; kk < 4; ++kk) o = MFMA32(lds_frag(att_ + (32 * lt + r) * 144 + (16 * kk + 8 * h) * 2), frag_tr(v_, 272, 16 * kk, 32 * vt, lane), o); \
        { const unsigned voff = (unsigned)(((dir ? 4 - 4 * h : 4 * h) * 512 + r) * 2); const int tb = dir ? (SEQ - 1 - 64 * (c) - 32 * lt - 4) : (64 * (c) + 32 * lt); \
          _Pragma("unroll") for (int i = 0; i < 16; ++i) { const int k_ = (i & 3) + 8 * (i >> 2); const int trow = dir ? tb - k_ : tb + k_; \
            char* ub = (char*)(oout + (size_t)(tokbase + trow) * 512 + hd * 128 + 32 * vt); *(u16*)(ub + voff) = f2bf(o[i]); } } \
        { \
            const int kt = lt; \
            _Pragma("unroll") for (int i = 0; i < 16; ++i) sacc[i] *= g63_[32 * kt + crow(i, h)]; \
            _Pragma("unroll") for (int kk = 0; kk < 4; ++kk) sacc = MFMA32(frag_tr(ke_, 144, 16 * kk, 32 * kt, lane), frag_tr(v_, 272, 16 * kk, 32 * vt, lane), sacc); \
            const int vv = 32 * vt + r; \
            _Pragma("unroll") for (int g4 = 0; g4 < 4; ++g4) { u32x2 w; w.x = pk(sacc[4 * g4], sacc[4 * g4 + 1]); w.y = pk(sacc[4 * g4 + 2], sacc[4 * g4 + 3]); \
                *(LAS u32x2*)(sbt_ + vv * 144 + (32 * kt + 8 * g4 + 4 * h) * 2) = w; } \
        } \
        __syncthreads(); } while (0)
#pragma unroll 1
    for (int c = 0; c < 32; c += 2) { GLA_BODY(c, RA); GLA_BODY(c + 1, RB); }
#undef GLA_BODY
#undef GLA_TOK
#undef GLA_LOADG
}

DI void post_token(const Params& p, int layer, char* grp, int g, int tg, int lane_in) {
    const int lane = opaque(lane_in);
    const u16* u = (const u16*)(grp + G_U);
    const size_t tglob = (size_t)g * TG + tg;
    { const u16* yf = (const u16*)(grp + G_YF); const u16* yb = (const u16*)(grp + G_YB); const u16* xc = (const u16*)(grp + G_XC);
      u16* aa = (u16*)(p.ws + OFF_AA); const float* ng = p.in[8] + layer * 1024; const float* ds = p.in[7] + layer * 16;
      float v[2][8]; float ss = 0.f;
#pragma unroll
      for (int i = 0; i < 2; ++i) { const int c = lane * 8 + 512 * i; float a[8], bb[8], x[8], z[8];
          unpack8(__builtin_nontemporal_load((const u32x4*)(yf + (size_t)tg * 1024 + c)), a); unpack8(__builtin_nontemporal_load((const u32x4*)(yb + (size_t)tg * 1024 + c)), bb);
          unpack8(__builtin_nontemporal_load((const u32x4*)(xc + (size_t)tg * 1536 + c)), x); unpack8(__builtin_nontemporal_load((const u32x4*)(u + (size_t)tg * UW + U_ZA + c)), z);
          const float dsk = ds[c >> 6];
#pragma unroll
          for (int j = 0; j < 8; ++j) { v[i][j] = (a[j] + bb[j] + x[j] * dsk) * z[j]; ss += v[i][j] * v[i][j]; } }
      ss = wave_sum(ss); const float rstd = rsqrtf(ss * (1.f / 1024.f) + EPS);
#pragma unroll
      for (int i = 0; i < 2; ++i) { const int c = lane * 8 + 512 * i; float o[8];
#pragma unroll
          for (int j = 0; j < 8; ++j) o[j] = v[i][j] * rstd * ng[c + j];
          *(u32x4*)(aa + tglob * 1024 + c) = pack8(o); } }
    { const u16* of = (const u16*)(grp + G_OF); const u16* ob = (const u16*)(grp + G_OB); u16* ac = (u16*)(p.ws + OFF_AC); const float* ng = p.in[15] + layer * 512;
      const int c = lane * 8; float a[8], bb[8], z[8], o[8]; float ss = 0.f;
      unpack8(__builtin_nontemporal_load((const u32x4*)(of + (size_t)tg * 512 + c)), a); unpack8(__builtin_nontemporal_load((const u32x4*)(ob + (size_t)tg * 512 + c)), bb); unpack8(__builtin_nontemporal_load((const u32x4*)(u + (size_t)tg * UW + U_ZC + c)), z);
#pragma unroll
      for (int j = 0; j < 8; ++j) { a[j] += bb[j]; ss += a[j] * a[j]; }
      ss += __shfl_xor(ss, 1); ss += __shfl_xor(ss, 2); ss += __shfl_xor(ss, 4); ss += __shfl_xor(ss, 8);
      const float rstd = rsqrtf(ss * (1.f / 128.f) + EPS);
#pragma unroll
      for (int j = 0; j < 8; ++j) o[j] = a[j] * rstd * ng[c + j] * z[j];
      *(u32x4*)(ac + tglob * 1024 + c) = pack8(o); }
}

__global__ void __launch_bounds__(512) mega(Params p) {
    extern __shared__ __attribute__((aligned(16))) char shm[];
    cg::grid_group grid = cg::this_grid();
    LAS unsigned char* lds = (LAS unsigned char*)shm;
    const int G = gridDim.x, bx = blockIdx.x;
    char* ws = p.ws; char* grp = ws + OFF_GRP;
    volatile LAS unsigned* xst = (volatile LAS unsigned*)(lds + STAGE_BYTES + 2048);
    if (threadIdx.x == 0) { xst[0] = 0u; xst[1] = 0u; }
    __syncthreads();
    const XcdBarrier xbar = xcd_barrier_post((unsigned*)(ws + OFF_BAR), xst);
#define GSYNC() xcd_barrier(xbar)
#pragma unroll 1
    for (int layer = 0; layer < 2; ++layer) {
        const float* xin = layer == 0 ? p.in[0] : p.out;
        phase_weights(shm, p, layer);
        phase_rownorm<false>(xin, p.in[1] + layer * 1024, (u16*)(ws + OFF_HB), nullptr);
        if (p.out == nullptr) grid.sync();
        GSYNC();
#pragma unroll 1
        for (int g = 0; g < NGROUP; ++g) {
            { pg8::Gemm gm{(const u16*)(ws + OFF_HB) + (size_t)g * TG * 1024, 1024, (const u16*)(ws + OFF_WALL) + (size_t)4096 * 1024, 1024, 1024};
              pg8::Strided S{gm, TG / 256, 16, bx, G, 0, gm.lda, gm.ldb};
              pg8::EpiInproj E{(u16*)(grp + G_U), (float*)(grp + G_DTRAW), (float*)(grp + G_GLR)};
              pg8::gemm_phase(lds, S, E); }
            GSYNC();
            { { pg8::Gemm gm{(const u16*)(ws + OFF_HB) + (size_t)g * TG * 1024, 1024, (const u16*)(ws + OFF_WALL) + (size_t)4096 * 1024, 1024, 1024};
                pg8::Strided S{gm, TG / 256, 4, bx, G, -1, gm.lda, gm.ldb};
                pg8::EpiInproj E{(u16*)(grp + G_U), (float*)(grp + G_DTRAW), (float*)(grp + G_GLR)};
                pg8::gemm_phase(lds, S, E); }
              unsigned* ctr = (unsigned*)(ws + OFF_CTR) + 16 + layer * 4 + g; volatile int* slot = (volatile int*)(shm + STAGE_BYTES + 2064);
              const int ngla = GSEQ * 32 * 4 * 2, nq = 32 * 3, nkv = 32 * 4, nconv = (TG / 16) * 3 / 8, ntok = TG / 32;
#pragma unroll 1
              for (;;) {
                __syncthreads();
                if (threadIdx.x == 0) *slot = (int)atomicAdd(ctr, 1u);
                __syncthreads();
                const int it0 = __builtin_amdgcn_readfirstlane(*slot);
                if (it0 >= ngla + nq + nkv + nconv + ntok) break;
                if (it0 < ngla) { gla_prep_task(shm, p, layer, grp, it0); continue; }
                const int it = it0 - ngla;
                if (it < nq) { const int pm = it / 3, pn = it % 3; rowstat<384>(shm, (const u16*)(grp + G_U) + U_QLAT, UW, pm * 256);
                  pg8::Gemm gm{(const u16*)(grp + G_U) + U_QLAT, UW, (const u16*)(ws + OFF_WQ), 384, 384}; pg8::OneUnit S{gm, pm, pn, gm.lda, gm.ldb};
                  pg8::EpiQ E{(u16*)(grp + G_QM), (const LAS float*)(shm + STAGE_BYTES)}; pg8::gemm_phase(lds, S, E); }
                else if (it < nq + nkv) { const int t = it - nq, pm = t >> 2, pn = t & 3; rowstat<256>(shm, (const u16*)(grp + G_U) + U_KVLAT, UW, pm * 256);
                  pg8::Gemm gm{(const u16*)(grp + G_U) + U_KVLAT, UW, (const u16*)(ws + OFF_WKV), 256, 256}; pg8::OneUnit S{gm, pm, pn, gm.lda, gm.ldb};
                  pg8::EpiKV E{(u16*)(grp + G_KM), (u16*)(grp + G_VM), (const LAS float*)(shm + STAGE_BYTES)}; pg8::gemm_phase(lds, S, E); }
                else { const int t_ = opaque(threadIdx.x); const int wave = __builtin_amdgcn_readfirstlane(t_ >> 6);
                  if (it < nq + nkv + nconv) conv_task(p, layer, grp, (it - nq - nkv) * 8 + wave, t_ & 63);
                  else prep_tokens<4>(p, layer, grp, (it - nq - nkv - nconv) * 32 + wave * 4, 1, t_ & 63); }
              } }
            GSYNC();
            { unsigned* ctr = (unsigned*)(ws + OFF_CTR) + layer * 4 + g; volatile int* slot = (volatile int*)(shm + STAGE_BYTES + 2064);
#pragma unroll 1
              for (;;) {
                __syncthreads();
                if (threadIdx.x == 0) *slot = (int)atomicAdd(ctr, 1u);
                __syncthreads();
                const int it = __builtin_amdgcn_readfirstlane(*slot);
                if (it >= 32 + 128 + 256 + 256 + 192) break;
                if (it < 32) gla_item(shm, p, layer, grp, it);
                else if (it < 160) ssd_item(shm, p, layer, grp, it - 32);
                else if (it < 416) { const int a = it - 160, b = a >> 6, hd = (a >> 3) & 7, qb = a & 7;
                    attn_item<96, true>(shm, (const u16*)(grp + G_QM) + hd * 96, 768, (const u16*)(grp + G_KM) + hd * 96, 768, (const u16*)(grp + G_VM) + hd * 64, 512,
                                        (const u16*)(grp + G_U) + U_ZB + hd * 64, UW, (u16*)(ws + OFF_AB) + (size_t)g * TG * 1024 + hd * 64, 1024, b * SEQ, qb * 256, 0.10206207261596577f); }
                else if (it >= 672) { const int zi = it - 672, pm = zi / 6, pl = zi % 6, pn = (pl < 4) ? 16 + pl : 18 + pl;
                    pg8::Gemm gm{(const u16*)(ws + OFF_HB) + (size_t)g * TG * 1024, 1024, (const u16*)(ws + OFF_WALL) + (size_t)4096 * 1024, 1024, 1024};
                    pg8::OneUnit S{gm, pm, pn, gm.lda, gm.ldb}; pg8::EpiInproj E{(u16*)(grp + G_U), (float*)(grp + G_DTRAW), (float*)(grp + G_GLR)};
                    pg8::gemm_phase(lds, S, E); }
                else { const int a = it - 416, b = a >> 6, hd = (a >> 3) & 7, qb = a & 7, kvh = hd >> 2;
                    attn_item<64, false>(shm, (const u16*)(grp + G_QG) + hd * 64, 512, (const u16*)(grp + G_KG) + kvh * 64, 128, (const u16*)(grp + G_U) + U_VD + kvh * 64, UW,
                                         (const u16*)(grp + G_U) + U_ZD + hd * 64, UW, (u16*)(ws + OFF_AD) + (size_t)g * TG * 1024 + hd * 64, 1024, b * SEQ, qb * 256, 0.125f); }
              } }
            GSYNC();
            { const int t_ = opaque(threadIdx.x); const int wave = __builtin_amdgcn_readfirstlane(t_ >> 6);
                for (int tg = bx * 8 + wave; tg < TG; tg += G * 8) post_token(p, layer, grp, g, tg, t_ & 63); }
            if (g == NGROUP - 1) GSYNC();
        }
        { u16* sgp = (u16*)(grp + P5_SCR + (size_t)bx * P5_SCR_PER); float* saccp = (float*)(grp + P5_SCR + (size_t)bx * P5_SCR_PER + 256 * 256 * 2);
          pg8::P5Sched S{ws, bx, G, 1024, 1024}; pg8::EpiP5 E{sgp, saccp, (u16*)(grp + P5_MIXED)};
          pg8::gemm_phase(lds, S, E); }
        GSYNC();
        { pg8::Gemm gm{(const u16*)(grp + P5_MIXED), 1024, (const u16*)(ws + OFF_WO), 1024, 1024}; pg8::Strided S{gm, 128, 4, bx, G, 0, gm.lda, gm.ldb};
          pg8::EpiOut E{xin, p.out}; pg8::gemm_phase(lds, S, E); }
        GSYNC();
    }
    phase_rownorm<true>(p.out, p.in[23], nullptr, p.out);
}

extern "C" void kernel_launch(void* const* d_in, const int* in_sizes, int n_in, void* d_out, int out_size, void* d_ws, size_t ws_size, hipStream_t stream) {
    static int grid_blocks = 0;
    if (grid_blocks == 0) {
        if (n_in != 24 || ws_size < WS_NEED) { fprintf(stderr, "kernel_launch: need 24 inputs and %zu bytes of workspace, got %d / %zu\n", (size_t)WS_NEED, n_in, ws_size); grid_blocks = -1; return; }
        int dev = 0, cus = 0, per_cu = 0;
        hipGetDevice(&dev);
        hipDeviceGetAttribute(&cus, hipDeviceAttributeMultiprocessorCount, dev);
        if (hipFuncSetAttribute((const void*)mega, hipFuncAttributeMaxDynamicSharedMemorySize, LDS_BYTES) != hipSuccess) { fprintf(stderr, "kernel_launch: hipFuncSetAttribute failed\n"); grid_blocks = -1; return; }
        hipOccupancyMaxActiveBlocksPerMultiprocessor(&per_cu, (const void*)mega, 512, LDS_BYTES);
        if (per_cu < 1) { fprintf(stderr, "kernel_launch: occupancy query says 0 blocks per CU\n"); per_cu = 1; }
        grid_blocks = cus * per_cu;
        if (grid_blocks > MAX_GRID) grid_blocks = MAX_GRID;
        grid_blocks &= ~7;
    }
    if (grid_blocks <= 0) return;
    if (hipMemsetAsync((char*)d_ws + OFF_CTR, 0, 4096 + 16384, stream) != hipSuccess) { fprintf(stderr, "kernel_launch: memset failed\n"); return; }
    Params p{};
    for (int i = 0; i < 24; ++i) p.in[i] = (const float*)d_in[i];
    p.out = (float*)d_out; p.ws = (char*)d_ws;
    void* args[] = {&p};
    hipError_t e = hipLaunchCooperativeKernel((const void*)mega, dim3(grid_blocks), dim3(512), args, LDS_BYTES, stream);
    if (e != hipSuccess) fprintf(stderr, "cooperative launch failed: %s (grid %d)\n", hipGetErrorString(e), grid_blocks);
}
```
